# Optimizing an MI355X kernel written in HIP

```python
import jax, jax.numpy as jnp
from jax import lax
import numpy as np

D_MODEL = 2048
BATCH = 4
SEQ = 2048
DEPTH = 1
DEC_BATCH = 128
DEC_SEQ = 1
PAST_LEN = 16384
PAGE_SIZE = 128

N_META = 16
MIX_WIDTH = D_MODEL
A_WIDTH = MIX_WIDTH // 2
B_WIDTH = MIX_WIDTH - A_WIDTH
A_EXPAND = 128
A_HEADS = A_WIDTH // A_EXPAND
A_DK = A_EXPAND
A_DV = A_WIDTH // A_HEADS
CHUNK = 64
CONV_W = 31
B_GROUPS = 8
D_FF = -(-8 * D_MODEL // (3 * 256)) * 256
IN_COLS = 4 * A_WIDTH + 2 * B_WIDTH
EPS = 1e-6

kernel_name = "hymba_hgrn2_conformer_conv_decode_step"


def _rmsnorm(x, g):
    xf = x.astype(jnp.float32)
    y = xf * lax.rsqrt(jnp.mean(xf * xf, axis=-1, keepdims=True) + EPS)
    return (y * g.astype(jnp.float32)).astype(x.dtype)


def _gla_chunk(S0, q, k, v, logf):
    C = q.shape[2]
    b = jnp.cumsum(logf, axis=2)
    mask = jnp.tril(jnp.ones((C, C), dtype=bool))[None, None, :, :, None]
    diff = b[:, :, :, None, :] - b[:, :, None, :, :]
    decay = jnp.exp(jnp.where(mask, diff, -jnp.inf))
    scores = jnp.einsum('bhtk,bhsk,bhtsk->bhts', q, k, decay)
    o = jnp.einsum('bhts,bhsv->bhtv', scores, v) + \
        jnp.einsum('bhtk,bhkv->bhtv', q * jnp.exp(b), S0)
    b_last = b[:, :, -1, :]
    S_new = jnp.exp(b_last)[..., None] * S0 + \
        jnp.einsum('bhsk,bhsv->bhkv', k * jnp.exp(b_last[:, :, None, :] - b), v)
    return o, S_new


def _hgrn_prompt(q, k, v, logf):
    B, H, T, _ = q.shape
    S0 = jnp.zeros((B, H, A_DK, A_DV), jnp.float32)
    o_meta, S = _gla_chunk(S0, q[:, :, :N_META], k[:, :, :N_META], v[:, :, :N_META], logf[:, :, :N_META])
    n_chunks = (T - N_META) // CHUNK

    def to_chunks(t):
        t = t[:, :, N_META:]
        return t.reshape(B, H, n_chunks, CHUNK, t.shape[-1]).transpose(2, 0, 1, 3, 4)

    def step(S_c, xs):
        qc, kc, vc, fc = xs
        o_c, S_n = _gla_chunk(S_c, qc, kc, vc, fc)
        return S_n, o_c

    S, o_rest = lax.scan(step, S, (to_chunks(q), to_chunks(k), to_chunks(v), to_chunks(logf)))
    o_rest = o_rest.transpose(1, 2, 0, 3, 4).reshape(B, H, n_chunks * CHUNK, A_DV)
    return jnp.concatenate([o_meta, o_rest], axis=2), S


def _layer(h, conv_buf, S0, is_prompt, lb, g_mix, w_in, hgrn_g, conv_w, conv_b, gn_g, gn_b,
           w_out, g_ffn, w_gate, w_up, w_down):
    B, T, _ = h.shape
    f32 = jnp.float32
    z = _rmsnorm(h, g_mix) @ w_in
    q, f, i, og, ga, gb = jnp.split(
        z, [A_WIDTH, 2 * A_WIDTH, 3 * A_WIDTH, 4 * A_WIDTH, 4 * A_WIDTH + B_WIDTH], axis=-1)

    def heads(t, d):
        return t.reshape(B, T, A_HEADS, d).transpose(0, 2, 1, 3).astype(f32)

    fgate = lb + (1.0 - lb) * jax.nn.sigmoid(f.astype(f32))
    qh = jax.nn.silu(heads(q, A_DK))
    kh = heads(1.0 - fgate, A_DK)
    logf = heads(jnp.log(fgate), A_DK)
    vh = heads(i, A_DV)
    if is_prompt:
        o, S_new = _hgrn_prompt(qh, kh, vh, logf)
    else:
        o, S_new = _gla_chunk(S0.astype(f32), qh, kh, vh, logf)
    o = o.transpose(0, 2, 1, 3)
    o = o * lax.rsqrt(jnp.mean(o * o, axis=-1, keepdims=True) + EPS) * hgrn_g.astype(f32).reshape(A_HEADS, A_DV)
    o_a = o.reshape(B, T, A_WIDTH) * jax.nn.silu(og.astype(f32))

    u = ga.astype(f32) * jax.nn.sigmoid(gb.astype(f32))
    ucat = jnp.concatenate([conv_buf.astype(f32), u], axis=1)
    c = lax.conv_general_dilated(ucat, conv_w.astype(f32)[:, None, :], window_strides=(1,),
                                 padding='VALID', dimension_numbers=('NWC', 'WIO', 'NWC'),
                                 feature_group_count=B_WIDTH) + conv_b.astype(f32)
    new_buf = ucat[:, -(CONV_W - 1):]
    cg = c.reshape(B, T, B_GROUPS, B_WIDTH // B_GROUPS)
    mu = jnp.mean(cg, axis=-1, keepdims=True)
    var = jnp.mean(jnp.square(cg - mu), axis=-1, keepdims=True)
    cn = ((cg - mu) * lax.rsqrt(var + EPS)).reshape(B, T, B_WIDTH) * gn_g.astype(f32) + gn_b.astype(f32)
    o_b = jax.nn.silu(cn)

    h = h + jnp.concatenate([o_a, o_b], axis=-1).astype(h.dtype) @ w_out

    hf = _rmsnorm(h, g_ffn)
    h = h + (jax.nn.silu(hf @ w_gate) * (hf @ w_up)) @ w_down
    return h, S_new, new_buf


def setup_inputs(seed: int = 0) -> dict:
    key = jax.random.key(seed)
    ks = jax.random.split(key, 20)
    n = jax.random.normal
    return {
        "x_prompt": n(ks[0], (BATCH, SEQ, D_MODEL), jnp.float32),
        "x_sample": n(ks[1], (DEC_BATCH, DEC_SEQ, D_MODEL), jnp.float32),
        "state_hgrn": 0.3 * n(ks[2], (DEPTH, DEC_BATCH, A_HEADS, A_DK, A_DV), jnp.float32),
        "state_conv": n(ks[3], (DEPTH, DEC_BATCH, CONV_W - 1, B_WIDTH), jnp.float32),
        "meta_tokens": n(ks[4], (N_META, D_MODEL), jnp.float32),
        "norm_mix_g": 1.0 + 0.02 * n(ks[5], (DEPTH, D_MODEL), jnp.float32),
        "w_in": n(ks[6], (DEPTH, D_MODEL, IN_COLS), jnp.float32) * D_MODEL ** -0.5,
        "lb_logits": 0.5 * n(ks[7], (DEPTH + 1, A_WIDTH), jnp.float32),
        "hgrn_norm_g": 1.0 + 0.02 * n(ks[8], (DEPTH, A_WIDTH), jnp.float32),
        "conv_w": n(ks[9], (DEPTH, CONV_W, B_WIDTH), jnp.float32) * CONV_W ** -0.5,
        "conv_b": 0.02 * n(ks[10], (DEPTH, B_WIDTH), jnp.float32),
        "gn_g": 1.0 + 0.02 * n(ks[11], (DEPTH, B_WIDTH), jnp.float32),
        "gn_b": 0.02 * n(ks[12], (DEPTH, B_WIDTH), jnp.float32),
        "w_out": n(ks[13], (DEPTH, MIX_WIDTH, D_MODEL), jnp.float32) * MIX_WIDTH ** -0.5,
        "norm_ffn_g": 1.0 + 0.02 * n(ks[14], (DEPTH, D_MODEL), jnp.float32),
        "w_ffn_gate": n(ks[15], (DEPTH, D_MODEL, D_FF), jnp.float32) * D_MODEL ** -0.5,
        "w_ffn_up": n(ks[16], (DEPTH, D_MODEL, D_FF), jnp.float32) * D_MODEL ** -0.5,
        "w_ffn_down": n(ks[17], (DEPTH, D_FF, D_MODEL), jnp.float32) * D_FF ** -0.5,
        "norm_final_g": 1.0 + 0.02 * n(ks[18], (D_MODEL,), jnp.float32),
    }


def reference(x_prompt, x_sample, state_hgrn, state_conv, meta_tokens, norm_mix_g, w_in, lb_logits,
              hgrn_norm_g, conv_w, conv_b, gn_g, gn_b, w_out, norm_ffn_g, w_ffn_gate, w_ffn_up,
              w_ffn_down, norm_final_g):
    lb_all = jnp.cumsum(jax.nn.softmax(lb_logits.astype(jnp.float32), axis=0), axis=0)

    hp = jnp.concatenate(
        [jnp.broadcast_to(meta_tokens.astype(x_prompt.dtype)[None], (x_prompt.shape[0], N_META, D_MODEL)), x_prompt],
        axis=1)
    hs = x_sample
    zero_buf = jnp.zeros((x_prompt.shape[0], CONV_W - 1, B_WIDTH), jnp.float32)

    sp_list, cp_list, ss_list, cs_list = [], [], [], []
    for l in range(DEPTH):
        p = (lb_all[l], norm_mix_g[l], w_in[l], hgrn_norm_g[l], conv_w[l], conv_b[l], gn_g[l], gn_b[l],
             w_out[l], norm_ffn_g[l], w_ffn_gate[l], w_ffn_up[l], w_ffn_down[l])
        hp, S_p, buf_p = _layer(hp, zero_buf, None, True, *p)
        hs, S_s, buf_s = _layer(hs, state_conv[l], state_hgrn[l], False, *p)
        sp_list.append(S_p.astype(x_prompt.dtype))
        cp_list.append(buf_p.astype(x_prompt.dtype))
        ss_list.append(S_s.astype(x_sample.dtype))
        cs_list.append(buf_s.astype(x_sample.dtype))

    y_prompt = _rmsnorm(hp, norm_final_g)[:, N_META:]
    y_sample = _rmsnorm(hs, norm_final_g)
    new_state_hgrn_prompt = jnp.stack(sp_list)
    new_state_conv_prompt = jnp.stack(cp_list)
    new_state_hgrn_sample = jnp.stack(ss_list)
    new_state_conv_sample = jnp.stack(cs_list)
    return (y_prompt, y_sample, new_state_hgrn_prompt, new_state_conv_prompt, new_state_hgrn_sample, new_state_conv_sample)
```

```cpp
#include <hip/hip_runtime.h>
#include <hip/hip_cooperative_groups.h>
#include <cstdio>
#include <cstdint>
namespace cg = cooperative_groups;
namespace pg8 {
#define PG8_LAS __attribute__((address_space(3)))
typedef unsigned short bf16_t;
typedef short bf16x8 __attribute__((ext_vector_type(8)));
typedef float f32x4 __attribute__((ext_vector_type(4)));
typedef unsigned u32x4 __attribute__((ext_vector_type(4)));
constexpr int BM = 256, BK = 64, HALF = 128, HTB = HALF * BK * 2  , STAGE_BYTES = 8 * HTB, NXCD = 8, WGM = 8;

__host__ __device__ __forceinline__ int lds_byte(int r, int c) { const int st = (r >> 4) * 2 + (c >> 5), rr = r & 15, cc = c & 31, ob = rr * 64 + cc * 2; return st * 1024 + (ob ^ (((ob >> 9) & 1) << 5)); }
__host__ __device__ __forceinline__ void stage_rc(int b, int& R, int& C) { const int st = b / 1024, sb = b % 1024, swz = sb ^ (((sb >> 9) & 1) << 5); R = (st >> 1) * 16 + swz / 64; C = (st & 1) * 32 + (swz % 64) / 2; }
__host__ __device__ __forceinline__ int perm32(int rho) { const int n = rho >> 4, i = rho & 15; return 8 * (i >> 2) + 4 * n + (i & 3); }

struct Unit { int pm, pn; };
struct Gemm { const bf16_t* A; const bf16_t* Bt; int M, N, K; };

struct StaticOrder {
    int nM, nN, nwg, G, c;
    __host__ __device__ void init(int M, int N, int G_, int c_) { nM = M / BM; nN = N / BM; nwg = nM * nN; G = G_; c = c_; }
    __host__ __device__ bool next(int i, Unit& u) const {
        const long L = (long)i * G + c; if (L >= nwg) return false;
        int wgid = (int)L; { const int q = nwg / NXCD, r = nwg % NXCD, xcd = wgid % NXCD, off = wgid / NXCD; wgid = (xcd < r ? xcd * (q + 1) : r * (q + 1) + (xcd - r) * q) + off; }
        const int nig = WGM * nN, gid = wgid / nig, fm = gid * WGM, gsz = (nM - fm) < WGM ? (nM - fm) : WGM;
        u.pm = fm + ((wgid % nig) % gsz); u.pn = (wgid % nig) / gsz; return true;
    }
    __device__ __forceinline__ void a_ready(const Unit&) const {}
    __device__ __forceinline__ void done(const Unit&) const {}
};
__device__ __forceinline__ unsigned cvt_pk_bf16(float lo, float hi) { unsigned r; asm volatile("v_cvt_pk_bf16_f32 %0, %1, %2" : "=v"(r) : "v"(lo), "v"(hi)); return r; }
template <class Epi, class Sched, bool ALIGN_EPI = false, bool SP2 = false>
__device__ __forceinline__ void gemm_phase(PG8_LAS unsigned char* lds, const Gemm g, const Sched& S, const Epi& E) {
    const int tid = threadIdx.x, wid = __builtin_amdgcn_readfirstlane(tid >> 6), lane = tid & 63, wr = wid >> 2, wc = wid & 3, fr = lane & 15, fq = lane >> 4;
    const int K = g.K, nt = K / BK;
    unsigned voffA[2], voffB[2];
#pragma unroll
    for (int i = 0; i < 2; ++i) { int R, C; stage_rc(tid * 16 + i * 8192, R, C); const int Rb = Epi::PERM ? ((R & ~31) + perm32(R & 31)) : R;
        voffA[i] = (unsigned)(R * K + C) * 2u; voffB[i] = (unsigned)(Rb * K + C) * 2u; }
    const size_t kstep = (size_t)(BK * 2);
    const size_t hstep = (size_t)HALF * K * 2;
    const size_t tstep = 2 * hstep;
    const unsigned ldsw = (unsigned)wid * 1024u;
    const int aoff = lds_byte(wr * 64 + fr, fq * 8), boff = lds_byte(wc * 32 + fr, fq * 8);
#define PG8_SA(b, h) (((b) * 2 + (h)) * HTB)
#define PG8_SB(b, h) ((4 + (b) * 2 + (h)) * HTB)
#define PG8_STAGE(bufoff, gbase, voff) do { _Pragma("unroll") for (int _i = 0; _i < 2; ++_i) \
        __builtin_amdgcn_global_load_lds((const unsigned*)((const char*)(gbase) + (voff)[_i]), (PG8_LAS unsigned*)(lds + (bufoff) + ldsw + _i * 8192), 16, 0, 0); } while (0)
#define PG8_LDA(dst, b, h) do { _Pragma("unroll") for (int m = 0; m < 4; ++m) _Pragma("unroll") for (int k = 0; k < 2; ++k) dst[m][k] = *(const PG8_LAS bf16x8*)(lds + PG8_SA(b, h) + aoff + m * 2048 + k * 1024); } while (0)
#define PG8_LDB(dst, b, h) do { _Pragma("unroll") for (int n = 0; n < 2; ++n) _Pragma("unroll") for (int k = 0; k < 2; ++k) dst[n][k] = *(const PG8_LAS bf16x8*)(lds + PG8_SB(b, h) + boff + n * 2048 + k * 1024); } while (0)
#define PG8_MMA(ai, bj, At, Bt) do { __builtin_amdgcn_s_setprio(1); _Pragma("unroll") for (int m = 0; m < 4; ++m) _Pragma("unroll") for (int n = 0; n < 2; ++n) _Pragma("unroll") for (int k = 0; k < 2; ++k) \
        acc[ai][bj][m][n] = __builtin_amdgcn_mfma_f32_16x16x32_bf16(Bt[n][k], At[m][k], acc[ai][bj][m][n], 0, 0, 0); __builtin_amdgcn_s_setprio(0); } while (0)
#define PG8_WAIT_V(n) asm volatile("s_waitcnt vmcnt(" #n ")" ::: "memory")
#define PG8_WAIT_L(n) asm volatile("s_waitcnt lgkmcnt(" #n ")" ::: "memory")
#define PG8_BAR __builtin_amdgcn_s_barrier()
#define PG8_SCHED __builtin_amdgcn_sched_barrier(0)
    Unit cur, nxt; int ui = 0;
    if (!S.next(0, cur)) return;
    f32x4 acc[2][2][4][2];
#pragma unroll
    for (int a = 0; a < 2; ++a)
#pragma unroll
        for (int b = 0; b < 2; ++b)
#pragma unroll
            for (int m = 0; m < 4; ++m)
#pragma unroll
                for (int n = 0; n < 2; ++n) acc[a][b][m][n] = (f32x4){0.f, 0.f, 0.f, 0.f};
    bf16x8 At[4][2], B0[2][2], B1[2][2];
    const char* cA = (const char*)g.A + (size_t)cur.pm * tstep; const char* cB = (const char*)g.Bt + (size_t)cur.pn * tstep;
    S.a_ready(cur);
    if constexpr (SP2) {
        PG8_STAGE(PG8_SB(0, 0), cB, voffB); PG8_STAGE(PG8_SB(0, 1), cB + hstep, voffB); PG8_STAGE(PG8_SA(0, 0), cA, voffA); PG8_STAGE(PG8_SA(0, 1), cA + hstep, voffA);
        if (wr == 1) PG8_BAR;
        PG8_WAIT_V(2); PG8_BAR;
        PG8_STAGE(PG8_SB(1, 0), cB + kstep, voffB); PG8_STAGE(PG8_SA(1, 0), cA + kstep, voffA); PG8_STAGE(PG8_SB(1, 1), cB + hstep + kstep, voffB);
        PG8_WAIT_V(6); PG8_BAR;
    } else {
        PG8_STAGE(PG8_SB(0, 0), cB, voffB); PG8_STAGE(PG8_SA(0, 0), cA, voffA); PG8_STAGE(PG8_SB(0, 1), cB + hstep, voffB); PG8_STAGE(PG8_SA(0, 1), cA + hstep, voffA);
        if (wr == 1) PG8_BAR;
        PG8_WAIT_V(4); PG8_BAR;
        PG8_STAGE(PG8_SB(1, 0), cB + kstep, voffB); PG8_STAGE(PG8_SA(1, 0), cA + kstep, voffA); PG8_STAGE(PG8_SB(1, 1), cB + hstep + kstep, voffB);
        PG8_WAIT_V(6); PG8_BAR;
    }
    for (;;) {
        const bool has_next = S.next(ui + 1, nxt);
        const char* nA = has_next ? (const char*)g.A + (size_t)nxt.pm * tstep : cA; const char* nB = has_next ? (const char*)g.Bt + (size_t)nxt.pn * tstep : cB;
        for (int t = 0; t < nt; t += 2) {
            const bool last = (t == nt - 2);
            const char* a1 = cA + (size_t)(t + 1) * kstep;
            const char* a2 = last ? nA : cA + (size_t)(t + 2) * kstep; const char* b2 = last ? nB : cB + (size_t)(t + 2) * kstep;
            const char* a3 = a2 + kstep; const char* b3 = b2 + kstep;
            if (last && has_next) S.a_ready(nxt);
            if constexpr (SP2) {
            PG8_LDB(B0, 0, 0); PG8_LDB(B1, 0, 1); PG8_SCHED; PG8_LDA(At, 0, 0); PG8_STAGE(PG8_SA(1, 1), a1 + hstep, voffA);
            PG8_WAIT_V(8); PG8_WAIT_L(0); PG8_BAR; PG8_MMA(0, 0, At, B0); PG8_MMA(0, 1, At, B1); PG8_BAR; PG8_SCHED;
            PG8_LDA(At, 0, 1); PG8_STAGE(PG8_SB(0, 0), b2, voffB); PG8_STAGE(PG8_SB(0, 1), b2 + hstep, voffB); PG8_STAGE(PG8_SA(0, 0), a2, voffA);
            PG8_WAIT_V(8); PG8_WAIT_L(0); PG8_BAR; PG8_MMA(1, 0, At, B0); PG8_MMA(1, 1, At, B1); PG8_BAR; PG8_SCHED;
            PG8_LDB(B0, 1, 0); PG8_LDB(B1, 1, 1); PG8_SCHED; PG8_LDA(At, 1, 0); PG8_STAGE(PG8_SA(0, 1), a2 + hstep, voffA);
            PG8_WAIT_V(8); PG8_WAIT_L(0); PG8_BAR; PG8_MMA(0, 0, At, B0); PG8_MMA(0, 1, At, B1); PG8_BAR; PG8_SCHED;
            PG8_LDA(At, 1, 1); PG8_STAGE(PG8_SB(1, 0), b3, voffB); PG8_STAGE(PG8_SB(1, 1), b3 + hstep, voffB); PG8_STAGE(PG8_SA(1, 0), a3, voffA);
            PG8_WAIT_V(8); PG8_WAIT_L(0); PG8_BAR; PG8_MMA(1, 0, At, B0); PG8_MMA(1, 1, At, B1); PG8_BAR; PG8_SCHED;
            } else {
            PG8_LDB(B0, 0, 0); PG8_SCHED; PG8_LDA(At, 0, 0); PG8_STAGE(PG8_SA(1, 1), a1 + hstep, voffA);
            PG8_WAIT_L(8); PG8_BAR; PG8_WAIT_L(0); PG8_MMA(0, 0, At, B0); PG8_BAR; PG8_SCHED;
            PG8_LDB(B1, 0, 1); PG8_STAGE(PG8_SB(0, 0), b2, voffB);
            PG8_BAR; PG8_WAIT_L(0); PG8_MMA(0, 1, At, B1); PG8_BAR;
            PG8_LDA(At, 0, 1); PG8_STAGE(PG8_SA(0, 0), a2, voffA);
            PG8_BAR; PG8_WAIT_L(0); PG8_MMA(1, 0, At, B0); PG8_BAR; PG8_SCHED;
            PG8_STAGE(PG8_SB(0, 1), b2 + hstep, voffB);
            PG8_WAIT_V(6); PG8_BAR; PG8_MMA(1, 1, At, B1); PG8_BAR;
            PG8_LDB(B0, 1, 0); PG8_SCHED; PG8_LDA(At, 1, 0); PG8_STAGE(PG8_SA(0, 1), a2 + hstep, voffA);
            PG8_WAIT_L(8); PG8_BAR; PG8_WAIT_L(0); PG8_MMA(0, 0, At, B0); PG8_BAR; PG8_SCHED;
            PG8_LDB(B1, 1, 1); PG8_STAGE(PG8_SB(1, 0), b3, voffB);
            PG8_BAR; PG8_WAIT_L(0); PG8_MMA(0, 1, At, B1); PG8_BAR;
            PG8_LDA(At, 1, 1); PG8_STAGE(PG8_SA(1, 0), a3, voffA);
            PG8_BAR; PG8_WAIT_L(0); PG8_MMA(1, 0, At, B0); PG8_BAR; PG8_SCHED;
            PG8_STAGE(PG8_SB(1, 1), b3 + hstep, voffB);
            PG8_WAIT_V(6); PG8_BAR; PG8_MMA(1, 1, At, B1); PG8_BAR;
            }
        }
        if constexpr (ALIGN_EPI) { if (wr == 0) PG8_BAR; }
        if constexpr (!Epi::AFTER_DRAIN) { E(acc, cur, wr, wc, fr, fq); S.done(cur); }
        if (!has_next) break;
#pragma unroll
        for (int a = 0; a < 2; ++a)
#pragma unroll
            for (int b = 0; b < 2; ++b)
#pragma unroll
                for (int m = 0; m < 4; ++m)
#pragma unroll
                    for (int n = 0; n < 2; ++n) acc[a][b][m][n] = (f32x4){0.f, 0.f, 0.f, 0.f};
        cur = nxt; cA = nA; cB = nB; ++ui;
        if constexpr (ALIGN_EPI) { if (wr == 1) PG8_BAR; }
    }
    PG8_WAIT_V(0);
    if constexpr (!ALIGN_EPI) { if (wr == 0) PG8_BAR; }
    PG8_BAR;
    if constexpr (Epi::AFTER_DRAIN) { E.fused(acc, cur, wr, wc, fr, fq, lds, wid, lane); S.done(cur); }
#undef PG8_SA
#undef PG8_SB
#undef PG8_STAGE
#undef PG8_LDA
#undef PG8_LDB
#undef PG8_MMA
#undef PG8_WAIT_V
#undef PG8_WAIT_L
#undef PG8_BAR
#undef PG8_SCHED
}
}

constexpr int D = 2048, NB = 4, SEQ = 2048, NMETA = 16, TP = SEQ + NMETA, MPROMPT = NB * TP, NS = 128, MREAL = MPROMPT + NS, MP = 8448;
constexpr int AW = 1024, NH = 8, NCHUNK = 33, CW = 31, FF = 5632, NIN = 6144, NITEM = NB * NH * NCHUNK;
constexpr float EPS = 1e-6f;
static_assert(MP % 256 == 0 && MP >= MREAL, "row padding");

constexpr size_t MiB = 1u << 20;
constexpr size_t WS_CTL = 0;
constexpr size_t WS_WIN = 1 * MiB, WS_WOUT = 25 * MiB, WS_WGU = 33 * MiB, WS_WD = 77 * MiB;
constexpr size_t WS_XN = 99 * MiB;
constexpr size_t WS_A2 = 132 * MiB;
constexpr size_t WS_QS = 165 * MiB, WS_V = WS_QS + 16896 * 1024, WS_G = WS_V + 16896 * 1024, WS_U = WS_G + 16896 * 1024;
constexpr size_t WS_LF = 231 * MiB;
constexpr size_t WS_SB = 264 * MiB;
constexpr size_t WS_AC = 297 * MiB;
constexpr size_t WS_A4 = 165 * MiB;
constexpr size_t WS_END = 298 * MiB;
static_assert(WS_A4 + (size_t)MP * FF * 2 <= WS_AC && WS_SB + (size_t)NITEM * 32768 <= WS_AC && WS_LF + (size_t)MP * 1024 * 4 <= WS_SB, "ws map");

constexpr int LDS_BYTES = 147456;
#define LAS __attribute__((address_space(3)))
typedef unsigned short bf16;
typedef unsigned v4u __attribute__((ext_vector_type(4)));
typedef unsigned v2u __attribute__((ext_vector_type(2)));
typedef float f32x4 __attribute__((ext_vector_type(4)));
typedef short bf16x8 __attribute__((ext_vector_type(8)));

__device__ __forceinline__ unsigned f2bf(float f) { unsigned u = __builtin_bit_cast(unsigned, f); return (u + 0x7fffu + ((u >> 16) & 1u)) >> 16; }
__device__ __forceinline__ unsigned pk2(float lo, float hi) { return f2bf(lo) | (f2bf(hi) << 16); }
__device__ __forceinline__ float bf2f(unsigned b) { return __builtin_bit_cast(float, b << 16); }
__device__ __forceinline__ float bflo(unsigned w) { return __builtin_bit_cast(float, w << 16); }
__device__ __forceinline__ float bfhi(unsigned w) { return __builtin_bit_cast(float, w & 0xffff0000u); }
__device__ __forceinline__ float sigmoidf_(float x) { return 1.f / (1.f + __expf(-x)); }
__device__ __forceinline__ float siluf_(float x) { return x / (1.f + __expf(-x)); }
__device__ __forceinline__ float wave_sum(float v) {
#pragma unroll
    for (int o = 1; o < 64; o <<= 1) v += __shfl_xor(v, o);
    return v;
}

struct Args { const float* in[19]; float* out; unsigned char* ws; int ph_lo, ph_hi; };
enum { I_XP = 0, I_XS, I_SH, I_SC, I_META, I_GMIX, I_WIN, I_LB, I_HG, I_CWT, I_CB, I_GNG, I_GNB, I_WOUT, I_GFFN, I_WG, I_WU, I_WD, I_GFIN };
constexpr size_t O_YP = 0, O_YS = (size_t)NB * SEQ * D, O_SHP = O_YS + (size_t)NS * D, O_SCP = O_SHP + (size_t)NB * NH * 128 * 128,
                 O_SHS = O_SCP + (size_t)NB * 30 * 1024, O_SCS = O_SHS + (size_t)NS * NH * 128 * 128, O_END = O_SCS + (size_t)NS * 30 * 1024;

struct RowMap { const float* xp; const float* xs; const float* meta; float* out; };
__device__ __forceinline__ const float* src_row(const RowMap& R, int r) {
    if (r >= MPROMPT) return R.xs + (size_t)(r - MPROMPT) * D;
    const int b = r / TP, t = r - b * TP;
    return t < NMETA ? R.meta + (size_t)t * D : R.xp + ((size_t)b * SEQ + (t - NMETA)) * D;
}
__device__ __forceinline__ float* out_row(const RowMap& R, int r) {
    if (r >= MPROMPT) return R.out + O_YS + (size_t)(r - MPROMPT) * D;
    const int b = r / TP, t = r - b * TP;
    return t < NMETA ? nullptr : R.out + O_YP + ((size_t)b * SEQ + (t - NMETA)) * D;
}

using pg8::Unit;
struct EpiIn {
    static constexpr bool PERM = true, AFTER_DRAIN = false;
    bf16* Qs; float* LF; bf16* V; bf16* G; bf16* U; const float* lbv;
    __device__ __forceinline__ void operator()(const f32x4 (&acc)[2][2][4][2], const Unit& u, int wr, int wc, int fr, int fq) const {
        const int row0 = u.pm * 256 + wr * 64 + fr;
        if (u.pn >= 16) {
            const int c0 = (u.pn - 16) * 128 + wc * 32 + 8 * fq;
#pragma unroll
            for (int ai = 0; ai < 2; ++ai)
#pragma unroll
                for (int m = 0; m < 4; ++m) {
                    const size_t row = (size_t)(row0 + ai * 128 + m * 16);
                    float o[8];
#pragma unroll
                    for (int n = 0; n < 2; ++n)
#pragma unroll
                        for (int j = 0; j < 4; ++j) o[n * 4 + j] = acc[ai][0][m][n][j] * sigmoidf_(acc[ai][1][m][n][j]);
                    v4u w; w.x = pg8::cvt_pk_bf16(o[0], o[1]); w.y = pg8::cvt_pk_bf16(o[2], o[3]); w.z = pg8::cvt_pk_bf16(o[4], o[5]); w.w = pg8::cvt_pk_bf16(o[6], o[7]);
                    *(v4u*)(U + row * 1024 + c0) = w;
                }
            return;
        }
        const int kind = u.pn >> 2, cb = (u.pn & 3) * 256 + wc * 32 + 8 * fq;
        if (kind == 1) {
            f32x4 lb[2][2];
#pragma unroll
            for (int bj = 0; bj < 2; ++bj)
#pragma unroll
                for (int n = 0; n < 2; ++n) lb[bj][n] = *(const f32x4*)(lbv + cb + bj * 128 + 4 * n);
#pragma unroll
            for (int ai = 0; ai < 2; ++ai)
#pragma unroll
                for (int m = 0; m < 4; ++m) {
                    const size_t row = (size_t)(row0 + ai * 128 + m * 16);
#pragma unroll
                    for (int bj = 0; bj < 2; ++bj)
#pragma unroll
                        for (int n = 0; n < 2; ++n) {
                            f32x4 o;
#pragma unroll
                            for (int j = 0; j < 4; ++j) { const float l = lb[bj][n][j]; o[j] = __logf(l + (1.f - l) * sigmoidf_(acc[ai][bj][m][n][j])); }
                            *(f32x4*)(LF + row * 1024 + cb + bj * 128 + 4 * n) = o;
                        }
                }
            return;
        }
        bf16* dst = Qs + (size_t)(kind == 0 ? 0 : kind - 1) * ((size_t)MP * 1024);
#pragma unroll
        for (int ai = 0; ai < 2; ++ai)
#pragma unroll
            for (int m = 0; m < 4; ++m) {
                const size_t row = (size_t)(row0 + ai * 128 + m * 16);
#pragma unroll
                for (int bj = 0; bj < 2; ++bj) {
                    float o[8];
#pragma unroll
                    for (int n = 0; n < 2; ++n)
#pragma unroll
                        for (int j = 0; j < 4; ++j) { const float x = acc[ai][bj][m][n][j]; o[n * 4 + j] = (kind == 2) ? x : siluf_(x); }
                    v4u w; w.x = pg8::cvt_pk_bf16(o[0], o[1]); w.y = pg8::cvt_pk_bf16(o[2], o[3]); w.z = pg8::cvt_pk_bf16(o[4], o[5]); w.w = pg8::cvt_pk_bf16(o[6], o[7]);
                    *(v4u*)(dst + row * 1024 + cb + bj * 128) = w;
                }
            }
    }
};

struct EpiOut {
    static constexpr bool PERM = true, AFTER_DRAIN = false;
    RowMap R; bf16* A3; const float* gffn; float* rowss;
    __device__ __forceinline__ void operator()(const f32x4 (&acc)[2][2][4][2], const Unit& u, int wr, int wc, int fr, int fq) const {
        const int row0 = u.pm * 256 + wr * 64 + fr, c0 = u.pn * 256 + wc * 32 + 8 * fq;
        f32x4 gv[2][2];
#pragma unroll
        for (int bj = 0; bj < 2; ++bj)
#pragma unroll
            for (int n = 0; n < 2; ++n) gv[bj][n] = *(const f32x4*)(gffn + c0 + bj * 128 + 4 * n);
#pragma unroll
        for (int ai = 0; ai < 2; ++ai)
#pragma unroll
            for (int m = 0; m < 4; ++m) {
                const int row = row0 + ai * 128 + m * 16;
                float ss = 0.f;
                if (row < MREAL) {
                    const float* src = src_row(R, row) + c0; float* dst = out_row(R, row);
#pragma unroll
                    for (int bj = 0; bj < 2; ++bj) {
                        f32x4 h[2];
#pragma unroll
                        for (int n = 0; n < 2; ++n) { h[n] = acc[ai][bj][m][n] + *(const f32x4*)(src + bj * 128 + 4 * n);
                            ss += (h[n][0] * h[n][0] + h[n][1] * h[n][1]) + (h[n][2] * h[n][2] + h[n][3] * h[n][3]);
                            if (dst) *(f32x4*)(dst + c0 + bj * 128 + 4 * n) = h[n]; }
                        const f32x4 a = h[0] * gv[bj][0], b = h[1] * gv[bj][1];
                        v4u w; w.x = pg8::cvt_pk_bf16(a[0], a[1]); w.y = pg8::cvt_pk_bf16(a[2], a[3]); w.z = pg8::cvt_pk_bf16(b[0], b[1]); w.w = pg8::cvt_pk_bf16(b[2], b[3]);
                        *(v4u*)(A3 + (size_t)row * D + c0 + bj * 128) = w;
                    }
                }
                ss += __shfl_xor(ss, 16); ss += __shfl_xor(ss, 32);
                if (fq == 0 && row < MREAL) atomicAdd(rowss + row, ss);
            }
    }
};

struct EpiGU {
    static constexpr bool PERM = true, AFTER_DRAIN = false;
    const float* rowss; bf16* A4;
    __device__ __forceinline__ void operator()(const f32x4 (&acc)[2][2][4][2], const Unit& u, int wr, int wc, int fr, int fq) const {
        const int row0 = u.pm * 256 + wr * 64 + fr, c0 = u.pn * 128 + wc * 32 + 8 * fq;
#pragma unroll
        for (int ai = 0; ai < 2; ++ai)
#pragma unroll
            for (int m = 0; m < 4; ++m) {
                const int row = row0 + ai * 128 + m * 16;
                const float rstd = rsqrtf(rowss[row] * (1.f / D) + EPS);
                float o[8];
#pragma unroll
                for (int n = 0; n < 2; ++n)
#pragma unroll
                    for (int j = 0; j < 4; ++j) o[n * 4 + j] = siluf_(acc[ai][0][m][n][j] * rstd) * (acc[ai][1][m][n][j] * rstd);
                v4u w; w.x = pg8::cvt_pk_bf16(o[0], o[1]); w.y = pg8::cvt_pk_bf16(o[2], o[3]); w.z = pg8::cvt_pk_bf16(o[4], o[5]); w.w = pg8::cvt_pk_bf16(o[6], o[7]);
                *(v4u*)(A4 + (size_t)row * FF + c0) = w;
            }
    }
};

struct EpiDown {
    static constexpr bool PERM = true, AFTER_DRAIN = false;
    RowMap R; float* rowss;
    __device__ __forceinline__ void operator()(const f32x4 (&acc)[2][2][4][2], const Unit& u, int wr, int wc, int fr, int fq) const {
        const int row0 = u.pm * 256 + wr * 64 + fr, c0 = u.pn * 256 + wc * 32 + 8 * fq;
#pragma unroll
        for (int ai = 0; ai < 2; ++ai)
#pragma unroll
            for (int m = 0; m < 4; ++m) {
                const int row = row0 + ai * 128 + m * 16;
                float ss = 0.f;
                float* dst = row < MREAL ? out_row(R, row) : nullptr;
                if (dst) {
#pragma unroll
                    for (int bj = 0; bj < 2; ++bj)
#pragma unroll
                        for (int n = 0; n < 2; ++n) { f32x4* p = (f32x4*)(dst + c0 + bj * 128 + 4 * n); const f32x4 h = *p + acc[ai][bj][m][n];
                            ss += (h[0] * h[0] + h[1] * h[1]) + (h[2] * h[2] + h[3] * h[3]); *p = h; }
                }
                ss += __shfl_xor(ss, 16); ss += __shfl_xor(ss, 32);
                if (fq == 0 && dst) atomicAdd(rowss + row, ss);
            }
    }
};

__device__ __forceinline__ void p0_transpose_item(const float* W, int K, int N, bf16* WT, int k0, int n0, int drow0, LAS float* scr, int lane) {
#pragma unroll 8
    for (int i = 0; i < 32; ++i) { const int kk = 2 * i + (lane >> 5); scr[kk * 33 + (lane & 31)] = W[(size_t)(k0 + kk) * N + n0 + (lane & 31)]; }
    asm volatile("s_waitcnt lgkmcnt(0)" ::: "memory");
    const int c = lane & 7;
#pragma unroll
    for (int j = 0; j < 4; ++j) { const int n = (lane >> 3) + 8 * j; const LAS float* s = scr + (8 * c) * 33 + n;
        v4u o; o.x = pk2(s[0 * 33], s[1 * 33]); o.y = pk2(s[2 * 33], s[3 * 33]); o.z = pk2(s[4 * 33], s[5 * 33]); o.w = pk2(s[6 * 33], s[7 * 33]);
        *(v4u*)(WT + (size_t)(drow0 + n) * K + k0 + 8 * c) = o; }
    asm volatile("s_waitcnt lgkmcnt(0)" ::: "memory");
}
__device__ __forceinline__ int glu_row(int n0) {
    if (n0 < 4096) return n0;
    if (n0 < 5120) { const int c = n0 - 4096; return 4096 + (c >> 7) * 256 + (c & 127); }
    const int c = n0 - 5120; return 4096 + (c >> 7) * 256 + 128 + (c & 127);
}
__device__ __forceinline__ void p0_prologue(const Args& a, LAS unsigned char* lds, int tid, int lane, int wave) {
    unsigned char* ws = a.ws;
    LAS float* scr = (LAS float*)(lds + wave * 16384);
    const int gw = blockIdx.x * 8 + wave, NGW = gridDim.x * 8;
    constexpr int I_IN = (D / 64) * (NIN / 32), I_OUT = (D / 64) * (D / 32), I_G = (D / 64) * (FF / 32), I_DN = (FF / 64) * (D / 32);
    constexpr int NITEMS = I_IN + I_OUT + 2 * I_G + I_DN;
    for (int it = gw; it < NITEMS; it += NGW) {
        int r = it;
        if (r < I_IN) { const int nblk = NIN / 32, kb = r / nblk, nb = r % nblk; p0_transpose_item(a.in[I_WIN], D, NIN, (bf16*)(ws + WS_WIN), 64 * kb, 32 * nb, glu_row(32 * nb), scr, lane); continue; } r -= I_IN;
        if (r < I_OUT) { const int nblk = D / 32, kb = r / nblk, nb = r % nblk; p0_transpose_item(a.in[I_WOUT], D, D, (bf16*)(ws + WS_WOUT), 64 * kb, 32 * nb, 32 * nb, scr, lane); continue; } r -= I_OUT;
        if (r < I_G) { const int nblk = FF / 32, kb = r / nblk, nb = r % nblk, n0 = 32 * nb; p0_transpose_item(a.in[I_WG], D, FF, (bf16*)(ws + WS_WGU), 64 * kb, n0, (n0 >> 7) * 256 + (n0 & 127), scr, lane); continue; } r -= I_G;
        if (r < I_G) { const int nblk = FF / 32, kb = r / nblk, nb = r % nblk, n0 = 32 * nb; p0_transpose_item(a.in[I_WU], D, FF, (bf16*)(ws + WS_WGU), 64 * kb, n0, (n0 >> 7) * 256 + 128 + (n0 & 127), scr, lane); continue; } r -= I_G;
        { const int nblk = D / 32, kb = r / nblk, nb = r % nblk; p0_transpose_item(a.in[I_WD], FF, D, (bf16*)(ws + WS_WD), 64 * kb, 32 * nb, 32 * nb, scr, lane); }
    }
    RowMap R{a.in[I_XP], a.in[I_XS], a.in[I_META], a.out};
    const float* gm = a.in[I_GMIX]; bf16* XN = (bf16*)(ws + WS_XN);
    for (int m = gw; m < MP; m += NGW) {
        v4u* o = (v4u*)(XN + (size_t)m * D) + lane;
        if (m >= MREAL) {
#pragma unroll
            for (int j = 0; j < 4; ++j) o[64 * j] = (v4u){0u, 0u, 0u, 0u};
            continue; }
        const f32x4* xr = (const f32x4*)src_row(R, m);
        f32x4 v[8]; float s = 0.f;
#pragma unroll
        for (int j = 0; j < 4; ++j) { v[2 * j] = xr[2 * lane + 128 * j]; v[2 * j + 1] = xr[2 * lane + 128 * j + 1]; }
#pragma unroll
        for (int j = 0; j < 8; ++j) s += (v[j][0] * v[j][0] + v[j][1] * v[j][1]) + (v[j][2] * v[j][2] + v[j][3] * v[j][3]);
        const float rstd = rsqrtf(wave_sum(s) * (1.f / D) + EPS);
#pragma unroll
        for (int j = 0; j < 4; ++j) { const f32x4 g0 = ((const f32x4*)gm)[2 * lane + 128 * j], g1 = ((const f32x4*)gm)[2 * lane + 128 * j + 1];
            const f32x4 a0 = v[2 * j] * rstd * g0, a1 = v[2 * j + 1] * rstd * g1;
            v4u w; w.x = pk2(a0[0], a0[1]); w.y = pk2(a0[2], a0[3]); w.z = pk2(a1[0], a1[1]); w.w = pk2(a1[2], a1[3]);
            o[64 * j] = w; }
    }
    float* ctl = (float*)(ws + WS_CTL);
    for (int i = blockIdx.x * 512 + tid; i < AW; i += gridDim.x * 512) { const float l0 = a.in[I_LB][i], l1 = a.in[I_LB][AW + i]; const float mx = fmaxf(l0, l1);
        const float e0 = __expf(l0 - mx), e1 = __expf(l1 - mx); ctl[i] = e0 / (e0 + e1); }
    for (int i = blockIdx.x * 512 + tid; i < MP; i += gridDim.x * 512) { ctl[16384 + i] = 0.f; ctl[32768 + i] = 0.f; }
}

constexpr int L_KT2 = 2048, L_TOT = 0, L_QP = 2048, L_QT = 19456, L_KT = 36864, L_VT = 54272, L_ST = 72704, L_PM = 107520, L_OB = 19456;
constexpr int RS_K = 136, RS_S = 72;
__device__ __forceinline__ void chunk_rows(int it, int& rowbase, int& nvalid, int& col0) {
    const int c = it % NCHUNK, bh = it / NCHUNK, h = bh & 7, b = bh >> 3;
    col0 = h * 128;
    if (c == 0) { rowbase = b * TP; nvalid = NMETA; } else { rowbase = b * TP + NMETA + (c - 1) * 64; nvalid = 64; }
}
__device__ __forceinline__ bf16x8 lds_frag(const LAS unsigned char* p) { return *(const LAS bf16x8*)p; }

__device__ __forceinline__ void hgrn_local(const Args& a, LAS unsigned char* lds, int tid, int lane, int wave) {
    unsigned char* ws = a.ws;
    const float* LF = (const float*)(ws + WS_LF); const bf16* V = (const bf16*)(ws + WS_V);
    bf16* SB = (bf16*)(ws + WS_SB); float* AC = (float*)(ws + WS_AC);
    LAS float* tot = (LAS float*)(lds + L_TOT);
    const int c_ = tid & 127, seg = tid >> 7;
    for (int it = blockIdx.x; it < NITEM; it += gridDim.x) {
        int rowbase, nvalid, col0; chunk_rows(it, rowbase, nvalid, col0);
        float lf[16], pre[16];
#pragma unroll
        for (int i = 0; i < 16; ++i) { const int s = seg * 16 + i; lf[i] = s < nvalid ? LF[(size_t)(rowbase + s) * 1024 + col0 + c_] : 0.f; }
        float run = 0.f;
#pragma unroll
        for (int i = 0; i < 16; ++i) { run += lf[i]; pre[i] = run; }
        tot[seg * 128 + c_] = run;
        unsigned vv[8];
#pragma unroll
        for (int i = 0; i < 8; ++i) { const int s = seg * 16 + 2 * i;
            const unsigned lo = s < nvalid ? V[(size_t)(rowbase + s) * 1024 + col0 + c_] : 0u, hi = s + 1 < nvalid ? V[(size_t)(rowbase + s + 1) * 1024 + col0 + c_] : 0u;
            vv[i] = lo | (hi << 16); }
        __syncthreads();
        const float t0 = tot[c_], t1 = tot[128 + c_], t2 = tot[256 + c_], t3 = tot[384 + c_];
        const float off = seg == 0 ? 0.f : (seg == 1 ? t0 : (seg == 2 ? t0 + t1 : t0 + t1 + t2)), blast = (t0 + t1) + (t2 + t3);
        unsigned kk[8];
#pragma unroll
        for (int i = 0; i < 8; ++i) {
            const float k0 = (1.f - __expf(lf[2 * i])) * __expf(blast - (off + pre[2 * i])), k1 = (1.f - __expf(lf[2 * i + 1])) * __expf(blast - (off + pre[2 * i + 1]));
            kk[i] = pk2(k0, k1); }
        LAS unsigned char* kt = lds + L_KT2 + c_ * (RS_S * 2) + seg * 32;
        LAS unsigned char* vt = lds + L_VT + c_ * (RS_S * 2) + seg * 32;
        *(LAS v4u*)kt = (v4u){kk[0], kk[1], kk[2], kk[3]}; *(LAS v4u*)(kt + 16) = (v4u){kk[4], kk[5], kk[6], kk[7]};
        *(LAS v4u*)vt = (v4u){vv[0], vv[1], vv[2], vv[3]}; *(LAS v4u*)(vt + 16) = (v4u){vv[4], vv[5], vv[6], vv[7]};
        if (seg == 0) AC[(size_t)it * 128 + c_] = __expf(blast);
        __syncthreads();
        const int r = lane & 15, q = lane >> 4;
        f32x4 acc[8];
#pragma unroll
        for (int n = 0; n < 8; ++n) acc[n] = (f32x4){0.f, 0.f, 0.f, 0.f};
#pragma unroll
        for (int ks = 0; ks < 2; ++ks) {
            const bf16x8 af = lds_frag(lds + L_KT2 + (wave * 16 + r) * (RS_S * 2) + (ks * 32 + q * 8) * 2);
#pragma unroll
            for (int n = 0; n < 8; ++n) { const bf16x8 bfm = lds_frag(lds + L_VT + (n * 16 + r) * (RS_S * 2) + (ks * 32 + q * 8) * 2);
                acc[n] = __builtin_amdgcn_mfma_f32_16x16x32_bf16(af, bfm, acc[n], 0, 0, 0); }
        }
        bf16* bt = SB + (size_t)it * 16384;
#pragma unroll
        for (int n = 0; n < 8; ++n) { v2u w; w.x = pk2(acc[n][0], acc[n][1]); w.y = pk2(acc[n][2], acc[n][3]);
            *(v2u*)(bt + (n * 16 + r) * 128 + wave * 16 + 4 * q) = w; }
        __syncthreads();
    }
}

__device__ __forceinline__ void hgrn_scan(const Args& a, int tid) {
    unsigned char* ws = a.ws; bf16* SB = (bf16*)(ws + WS_SB); const float* AC = (const float*)(ws + WS_AC);
    float* outS = a.out + O_SHP;
    for (int g = blockIdx.x * 512 + tid; g < NB * NH * 128 * 32; g += gridDim.x * 512) {
        const int bh = g >> 12, rem = g & 4095, v = rem >> 5, k4 = rem & 31;
        float S0 = 0.f, S1 = 0.f, S2 = 0.f, S3 = 0.f;
#pragma unroll 3
        for (int c = 0; c < NCHUNK; ++c) {
            const size_t it = (size_t)bh * NCHUNK + c;
            const f32x4 dec = *(const f32x4*)(AC + it * 128 + 4 * k4);
            v2u* p = (v2u*)(SB + it * 16384 + v * 128 + 4 * k4);
            const v2u bw = *p;
            v2u sw; sw.x = pk2(S0, S1); sw.y = pk2(S2, S3); *p = sw;
            S0 = dec[0] * S0 + bflo(bw.x); S1 = dec[1] * S1 + bfhi(bw.x); S2 = dec[2] * S2 + bflo(bw.y); S3 = dec[3] * S3 + bfhi(bw.y);
        }
        float* o = outS + ((size_t)bh * 128 + 4 * k4) * 128 + v;
        o[0] = S0; o[128] = S1; o[256] = S2; o[384] = S3;
    }
}

__device__ __forceinline__ void hgrn_out(const Args& a, LAS unsigned char* lds, int tid, int lane, int wave) {
    unsigned char* ws = a.ws;
    const float* LF = (const float*)(ws + WS_LF); const bf16* V = (const bf16*)(ws + WS_V); const bf16* Qs = (const bf16*)(ws + WS_QS); const bf16* G = (const bf16*)(ws + WS_G);
    const bf16* SB = (const bf16*)(ws + WS_SB); bf16* A2 = (bf16*)(ws + WS_A2); const float* hg = a.in[I_HG];
    LAS float* tot = (LAS float*)(lds + L_TOT);
    const int c_ = tid & 127, seg = tid >> 7;
    for (int it = blockIdx.x; it < NITEM; it += gridDim.x) {
        int rowbase, nvalid, col0; chunk_rows(it, rowbase, nvalid, col0);
        float lf[16], pre[16];
#pragma unroll
        for (int i = 0; i < 16; ++i) { const int s = seg * 16 + i; lf[i] = s < nvalid ? LF[(size_t)(rowbase + s) * 1024 + col0 + c_] : 0.f; }
        float run = 0.f;
#pragma unroll
        for (int i = 0; i < 16; ++i) { run += lf[i]; pre[i] = run; }
        tot[seg * 128 + c_] = run;
        unsigned vv[8];
#pragma unroll
        for (int i = 0; i < 8; ++i) { const int s = seg * 16 + 2 * i;
            const unsigned lo = s < nvalid ? V[(size_t)(rowbase + s) * 1024 + col0 + c_] : 0u, hi = s + 1 < nvalid ? V[(size_t)(rowbase + s + 1) * 1024 + col0 + c_] : 0u;
            vv[i] = lo | (hi << 16); }
        { LAS unsigned char* vt = lds + L_VT + c_ * (RS_S * 2) + seg * 32;
          *(LAS v4u*)vt = (v4u){vv[0], vv[1], vv[2], vv[3]}; *(LAS v4u*)(vt + 16) = (v4u){vv[4], vv[5], vv[6], vv[7]}; }
        { const v4u* sp = (const v4u*)(SB + (size_t)it * 16384);
#pragma unroll
          for (int j = 0; j < 4; ++j) { const int id = tid + 512 * j, v = id >> 4, kc = id & 15; *(LAS v4u*)(lds + L_ST + v * (RS_K * 2) + kc * 16) = sp[id]; } }
        float qv[16];
#pragma unroll
        for (int i = 0; i < 16; ++i) { const int s = seg * 16 + i; qv[i] = s < nvalid ? bf2f(Qs[(size_t)(rowbase + s) * 1024 + col0 + c_]) : 0.f; }
        __syncthreads();
        const float t0 = tot[c_], t1 = tot[128 + c_], t2 = tot[256 + c_];
        const float off = seg == 0 ? 0.f : (seg == 1 ? t0 : (seg == 2 ? t0 + t1 : t0 + t1 + t2)), bref = t0 + t1;
#pragma unroll
        for (int i = 0; i < 16; ++i) {
            const int s = seg * 16 + i; const float b = off + pre[i];
            const float qp = qv[i] * __expf(b), qt = qv[i] * __expf(fminf(b - bref, 80.f)), kt = (1.f - __expf(lf[i])) * __expf(fminf(bref - b, 80.f));
            ((LAS bf16*)(lds + L_QP))[s * RS_K + c_] = (bf16)f2bf(qp);
            ((LAS bf16*)(lds + L_QT))[s * RS_K + c_] = (bf16)f2bf(qt);
            ((LAS bf16*)(lds + L_KT))[s * RS_K + c_] = (bf16)f2bf(kt);
        }
        __syncthreads();
        const int r = lane & 15, q = lane >> 4;
        {
            const int sb = wave & 3, tb0 = (wave >> 2) * 2;
            f32x4 sc[2] = {(f32x4){0.f, 0.f, 0.f, 0.f}, (f32x4){0.f, 0.f, 0.f, 0.f}};
#pragma unroll
            for (int ks = 0; ks < 4; ++ks) {
                const bf16x8 af = lds_frag(lds + L_KT + (sb * 16 + r) * (RS_K * 2) + (ks * 32 + q * 8) * 2);
#pragma unroll
                for (int n = 0; n < 2; ++n) { const bf16x8 bfm = lds_frag(lds + L_QT + ((tb0 + n) * 16 + r) * (RS_K * 2) + (ks * 32 + q * 8) * 2);
                    sc[n] = __builtin_amdgcn_mfma_f32_16x16x32_bf16(af, bfm, sc[n], 0, 0, 0); }
            }
#pragma unroll
            for (int n = 0; n < 2; ++n) { const int t = (tb0 + n) * 16 + r, s0 = sb * 16 + 4 * q;
                const float p0 = s0 <= t ? sc[n][0] : 0.f, p1 = s0 + 1 <= t ? sc[n][1] : 0.f, p2 = s0 + 2 <= t ? sc[n][2] : 0.f, p3 = s0 + 3 <= t ? sc[n][3] : 0.f;
                v2u w; w.x = pk2(p0, p1); w.y = pk2(p2, p3);
                *(LAS v2u*)(lds + L_PM + t * (RS_S * 2) + s0 * 2) = w; }
        }
        __syncthreads();
        {
            const int tb = wave & 3, nv0 = (wave >> 2) * 4;
            f32x4 oc[4];
#pragma unroll
            for (int n = 0; n < 4; ++n) oc[n] = (f32x4){0.f, 0.f, 0.f, 0.f};
#pragma unroll
            for (int ks = 0; ks < 2; ++ks) {
                const bf16x8 af = lds_frag(lds + L_PM + (tb * 16 + r) * (RS_S * 2) + (ks * 32 + q * 8) * 2);
#pragma unroll
                for (int n = 0; n < 4; ++n) { const bf16x8 bfm = lds_frag(lds + L_VT + ((nv0 + n) * 16 + r) * (RS_S * 2) + (ks * 32 + q * 8) * 2);
                    oc[n] = __builtin_amdgcn_mfma_f32_16x16x32_bf16(af, bfm, oc[n], 0, 0, 0); }
            }
#pragma unroll
            for (int ks = 0; ks < 4; ++ks) {
                const bf16x8 af = lds_frag(lds + L_QP + (tb * 16 + r) * (RS_K * 2) + (ks * 32 + q * 8) * 2);
#pragma unroll
                for (int n = 0; n < 4; ++n) { const bf16x8 bfm = lds_frag(lds + L_ST + ((nv0 + n) * 16 + r) * (RS_K * 2) + (ks * 32 + q * 8) * 2);
                    oc[n] = __builtin_amdgcn_mfma_f32_16x16x32_bf16(af, bfm, oc[n], 0, 0, 0); }
            }
#pragma unroll
            for (int n = 0; n < 4; ++n)
#pragma unroll
                for (int j = 0; j < 4; ++j) ((LAS float*)(lds + L_OB))[(tb * 16 + 4 * q + j) * 132 + (nv0 + n) * 16 + r] = oc[n][j];
        }
        __syncthreads();
        {
            const int t = tid >> 3, part = tid & 7, v0 = part * 16;
            const LAS f32x4* op = (const LAS f32x4*)(lds + L_OB + (t * 132 + v0) * 4);
            f32x4 o4[4]; float ss = 0.f;
#pragma unroll
            for (int j = 0; j < 4; ++j) { o4[j] = op[j]; ss += (o4[j][0] * o4[j][0] + o4[j][1] * o4[j][1]) + (o4[j][2] * o4[j][2] + o4[j][3] * o4[j][3]); }
            ss += __shfl_xor(ss, 1); ss += __shfl_xor(ss, 2); ss += __shfl_xor(ss, 4);
            const float rstd = rsqrtf(ss * (1.f / 128.f) + EPS);
            if (t < nvalid) {
                const size_t row = (size_t)(rowbase + t);
                const v4u* gp = (const v4u*)(G + row * 1024 + col0 + v0); const f32x4* hp = (const f32x4*)(hg + col0 + v0);
                v4u* dst = (v4u*)(A2 + row * D + col0 + v0);
#pragma unroll
                for (int hhalf = 0; hhalf < 2; ++hhalf) { const v4u gw = gp[hhalf]; const f32x4 h0 = hp[2 * hhalf], h1 = hp[2 * hhalf + 1]; const f32x4 x0 = o4[2 * hhalf] * rstd * h0, x1 = o4[2 * hhalf + 1] * rstd * h1;
                    v4u w; w.x = pk2(x0[0] * bflo(gw.x), x0[1] * bfhi(gw.x)); w.y = pk2(x0[2] * bflo(gw.y), x0[3] * bfhi(gw.y));
                    w.z = pk2(x1[0] * bflo(gw.z), x1[1] * bfhi(gw.z)); w.w = pk2(x1[2] * bflo(gw.w), x1[3] * bfhi(gw.w));
                    dst[hhalf] = w; }
            }
        }
        __syncthreads();
    }
}

__device__ __forceinline__ void conv_prompt(const Args& a, LAS unsigned char* lds, int tid, int lane, int wave) {
    unsigned char* ws = a.ws; const bf16* U = (const bf16*)(ws + WS_U); bf16* A2 = (bf16*)(ws + WS_A2);
    const float* cw = a.in[I_CWT]; const float* cb = a.in[I_CB]; const float* gng = a.in[I_GNG]; const float* gnb = a.in[I_GNB];
    LAS float* red = (LAS float*)lds;
    constexpr int NTT = (TP + 31) / 32;
    for (int it = blockIdx.x; it < NB * NTT * 4; it += gridDim.x) {
        const int cbk = it & 3, tt = (it >> 2) % NTT, b = (it >> 2) / NTT;
        const int ch = cbk * 256 + (tid & 255), t0 = tt * 32 + (tid >> 8) * 16;
        float w[CW];
#pragma unroll
        for (int j = 0; j < CW; ++j) w[j] = cw[j * 1024 + ch];
        float uw[46];
#pragma unroll
        for (int j = 0; j < 46; ++j) { const int tok = t0 - 30 + j; uw[j] = (tok >= 0 && tok < TP) ? bf2f(U[(size_t)(b * TP + tok) * 1024 + ch]) : 0.f; }
        const float bias = cb[ch];
        float c[16];
#pragma unroll
        for (int i = 0; i < 16; ++i) { float s = bias;
#pragma unroll
            for (int j = 0; j < CW; ++j) s += w[j] * uw[i + j];
            c[i] = s; }
#pragma unroll
        for (int i = 0; i < 16; ++i) { const float s1 = wave_sum(c[i]), s2 = wave_sum(c[i] * c[i]); if (lane == 0) { red[(wave * 16 + i) * 2] = s1; red[(wave * 16 + i) * 2 + 1] = s2; } }
        __syncthreads();
        const float gg = gng[ch], gb = gnb[ch];
#pragma unroll
        for (int i = 0; i < 16; ++i) {
            const float s1 = red[(wave * 16 + i) * 2] + red[((wave ^ 1) * 16 + i) * 2], s2 = red[(wave * 16 + i) * 2 + 1] + red[((wave ^ 1) * 16 + i) * 2 + 1];
            const float mu = s1 * (1.f / 128.f), var = fmaxf(s2 * (1.f / 128.f) - mu * mu, 0.f);
            const float cn = (c[i] - mu) * rsqrtf(var + EPS) * gg + gb;
            const int tok = t0 + i;
            if (tok < TP) A2[(size_t)(b * TP + tok) * D + 1024 + ch] = (bf16)f2bf(siluf_(cn));
        }
        __syncthreads();
    }
    float* o = a.out + O_SCP;
    for (int i = blockIdx.x * 512 + tid; i < NB * 30 * 1024; i += gridDim.x * 512) { const int ch = i & 1023, j = (i >> 10) % 30, b = (i >> 10) / 30;
        o[i] = bf2f(U[(size_t)(b * TP + TP - 30 + j) * 1024 + ch]); }
}
__device__ __forceinline__ void conv_sample(const Args& a, LAS unsigned char* lds, int tid, int lane, int wave) {
    unsigned char* ws = a.ws; const bf16* U = (const bf16*)(ws + WS_U); bf16* A2 = (bf16*)(ws + WS_A2);
    const float* cw = a.in[I_CWT]; const float* cb = a.in[I_CB]; const float* gng = a.in[I_GNG]; const float* gnb = a.in[I_GNB];
    const float* sc = a.in[I_SC]; float* o = a.out + O_SCS;
    LAS float* red = (LAS float*)lds;
    for (int it = blockIdx.x; it < NS * 2; it += gridDim.x) {
        const int sb = it >> 1, ch = (it & 1) * 512 + tid;
        const float* st = sc + (size_t)sb * 30 * 1024 + ch; float* ot = o + (size_t)sb * 30 * 1024 + ch;
        const float un = bf2f(U[(size_t)(MPROMPT + sb) * 1024 + ch]);
        float s = cb[ch];
#pragma unroll
        for (int j = 0; j < 30; ++j) { const float x = st[j * 1024]; s += cw[j * 1024 + ch] * x; if (j >= 1) ot[(j - 1) * 1024] = x; }
        s += cw[30 * 1024 + ch] * un; ot[29 * 1024] = un;
        const float s1 = wave_sum(s), s2 = wave_sum(s * s);
        if (lane == 0) { red[wave * 2] = s1; red[wave * 2 + 1] = s2; }
        __syncthreads();
        const float a1 = red[wave * 2] + red[(wave ^ 1) * 2], a2 = red[wave * 2 + 1] + red[(wave ^ 1) * 2 + 1];
        const float mu = a1 * (1.f / 128.f), var = fmaxf(a2 * (1.f / 128.f) - mu * mu, 0.f);
        const float cn = (s - mu) * rsqrtf(var + EPS) * gng[ch] + gnb[ch];
        A2[(size_t)(MPROMPT + sb) * D + 1024 + ch] = (bf16)f2bf(siluf_(cn));
        __syncthreads();
    }
}
__device__ __forceinline__ void hgrn_sample(const Args& a, LAS unsigned char* lds, int tid, int lane, int wave) {
    unsigned char* ws = a.ws;
    const float* LF = (const float*)(ws + WS_LF); const bf16* V = (const bf16*)(ws + WS_V); const bf16* Qs = (const bf16*)(ws + WS_QS); const bf16* G = (const bf16*)(ws + WS_G);
    bf16* A2 = (bf16*)(ws + WS_A2); const float* hg = a.in[I_HG]; const float* S0 = a.in[I_SH]; float* So = a.out + O_SHS;
    LAS float* qf = (LAS float*)lds;
    LAS float* red = (LAS float*)(lds + 4096);
    LAS float* r2 = (LAS float*)(lds + 4096 + 8192);
    for (int it = blockIdx.x; it < NS * NH; it += gridDim.x) {
        const int sb = it >> 3, h = it & 7; const size_t row = (size_t)(MPROMPT + sb);
        if (tid < 128) { const size_t idx = row * 1024 + h * 128 + tid; const float f = __expf(LF[idx]);
            qf[tid] = bf2f(Qs[idx]); qf[128 + tid] = f; qf[256 + tid] = 1.f - f; qf[384 + tid] = bf2f(V[idx]); }
        __syncthreads();
        const int v4 = tid & 31, ks = tid >> 5;
        const f32x4 vv = *(const LAS f32x4*)(qf + 384 + 4 * v4);
        const float* sp = S0 + (size_t)it * 16384; float* so = So + (size_t)it * 16384;
        f32x4 o = (f32x4){0.f, 0.f, 0.f, 0.f};
#pragma unroll
        for (int i = 0; i < 8; ++i) { const int k = ks * 8 + i; const f32x4 s = *(const f32x4*)(sp + k * 128 + 4 * v4);
            const f32x4 sn = s * qf[128 + k] + vv * qf[256 + k]; *(f32x4*)(so + k * 128 + 4 * v4) = sn; o += sn * qf[k]; }
        *(LAS f32x4*)(red + ks * 128 + 4 * v4) = o;
        __syncthreads();
        float ov = 0.f;
        if (tid < 128) {
#pragma unroll
            for (int j = 0; j < 16; ++j) ov += red[j * 128 + tid];
            const float ss = wave_sum(ov * ov); if (lane == 0) r2[wave] = ss; }
        __syncthreads();
        if (tid < 128) { const float rstd = rsqrtf((r2[0] + r2[1]) * (1.f / 128.f) + EPS); const size_t idx = row * 1024 + h * 128 + tid;
            A2[row * D + h * 128 + tid] = (bf16)f2bf(ov * rstd * hg[h * 128 + tid] * bf2f(G[idx])); }
        __syncthreads();
    }
}

__device__ __forceinline__ void final_norm(const Args& a, int lane, int wave) {
    RowMap R{a.in[I_XP], a.in[I_XS], a.in[I_META], a.out};
    const float* rowss = (const float*)(a.ws + WS_CTL) + 32768; const f32x4* g = (const f32x4*)a.in[I_GFIN];
    for (int m = blockIdx.x * 8 + wave; m < MREAL; m += gridDim.x * 8) {
        float* dst = out_row(R, m); if (!dst) continue;
        const float rstd = rsqrtf(rowss[m] * (1.f / D) + EPS);
        f32x4* p = (f32x4*)dst + lane;
#pragma unroll
        for (int j = 0; j < 8; ++j) p[64 * j] = p[64 * j] * rstd * g[lane + 64 * j];
    }
}

constexpr int NPHASE = 9;
__global__ void __launch_bounds__(512, 2) hymba_fwd(Args args) {
    extern __shared__ __attribute__((aligned(16))) unsigned char lds_raw[];
    LAS unsigned char* lds = (LAS unsigned char*)lds_raw;
    cg::grid_group grid = cg::this_grid();
    const int tid = threadIdx.x, lane = tid & 63, wave = __builtin_amdgcn_readfirstlane(tid >> 6);
    unsigned char* ws = args.ws;
    const int lo = args.ph_lo, hi = args.ph_hi;
#define IN(k) (lo <= (k) && (k) < hi)
#define SEAM(k) do { if (IN(k) && IN((k) + 1)) grid.sync(); } while (0)
    RowMap R{args.in[I_XP], args.in[I_XS], args.in[I_META], args.out};
    if (IN(0)) { p0_prologue(args, lds, tid, lane, wave); }
    SEAM(0);
    if (IN(1)) {
        pg8::Gemm g{(const bf16*)(ws + WS_XN), (const bf16*)(ws + WS_WIN), MP, NIN, D}; pg8::StaticOrder S; S.init(MP, NIN, gridDim.x, (int)blockIdx.x);
        EpiIn E{(bf16*)(ws + WS_QS), (float*)(ws + WS_LF), (bf16*)(ws + WS_V), (bf16*)(ws + WS_G), (bf16*)(ws + WS_U), (const float*)(ws + WS_CTL)};
        pg8::gemm_phase<EpiIn, pg8::StaticOrder, true, true>(lds, g, S, E);
    }
    SEAM(1);
    if (IN(2)) { hgrn_local(args, lds, tid, lane, wave); conv_prompt(args, lds, tid, lane, wave); conv_sample(args, lds, tid, lane, wave); hgrn_sample(args, lds, tid, lane, wave); }
    SEAM(2);
    if (IN(3)) { hgrn_scan(args, tid); }
    SEAM(3);
    if (IN(4)) { hgrn_out(args, lds, tid, lane, wave); }
    SEAM(4);
    if (IN(5)) {
        pg8::Gemm g{(const bf16*)(ws + WS_A2), (const bf16*)(ws + WS_WOUT), MP, D, D}; pg8::StaticOrder S; S.init(MP, D, gridDim.x, (int)blockIdx.x);
        EpiOut E{R, (bf16*)(ws + WS_XN), args.in[I_GFFN], (float*)(ws + WS_CTL) + 16384};
        pg8::gemm_phase<EpiOut, pg8::StaticOrder, true, true>(lds, g, S, E);
    }
    SEAM(5);
    if (IN(6)) {
        pg8::Gemm g{(const bf16*)(ws + WS_XN), (const bf16*)(ws + WS_WGU), MP, 2 * FF, D}; pg8::StaticOrder S; S.init(MP, 2 * FF, gridDim.x, (int)blockIdx.x);
        EpiGU E{(const float*)(ws + WS_CTL) + 16384, (bf16*)(ws + WS_A4)};
        pg8::gemm_phase<EpiGU, pg8::StaticOrder, true, true>(lds, g, S, E);
    }
    SEAM(6);
    if (IN(7)) {
        pg8::Gemm g{(const bf16*)(ws + WS_A4), (const bf16*)(ws + WS_WD), MP, D, FF}; pg8::StaticOrder S; S.init(MP, D, gridDim.x, (int)blockIdx.x);
        EpiDown E{R, (float*)(ws + WS_CTL) + 32768};
        pg8::gemm_phase<EpiDown, pg8::StaticOrder, true, true>(lds, g, S, E);
    }
    SEAM(7);
    if (IN(8)) { final_norm(args, lane, wave); }
#undef IN
#undef SEAM
}

#ifndef MK_N_LAUNCHES
#define MK_N_LAUNCHES 1
#endif
extern "C" void kernel_launch(void* const* d_in, const int* in_sizes, int n_in, void* d_out, int out_size, void* d_ws, size_t ws_size, hipStream_t stream) {
    static int grid = 0;
    if (grid == 0) {
        if (n_in != 19 || (size_t)out_size != O_END || ws_size < WS_END) { fprintf(stderr, "kernel_launch: unexpected shapes: n_in %d out %d ws %zu (need %zu)\n", n_in, out_size, ws_size, (size_t)WS_END); grid = -1; return; }
        int dev = 0, cus = 0, per_cu = 0;
        if (hipGetDevice(&dev) != hipSuccess || hipDeviceGetAttribute(&cus, hipDeviceAttributeMultiprocessorCount, dev) != hipSuccess) { grid = -1; return; }
        if (hipFuncSetAttribute((const void*)hymba_fwd, hipFuncAttributeMaxDynamicSharedMemorySize, LDS_BYTES) != hipSuccess) { fprintf(stderr, "kernel_launch: hipFuncSetAttribute failed\n"); grid = -1; return; }
        if (hipOccupancyMaxActiveBlocksPerMultiprocessor(&per_cu, (const void*)hymba_fwd, 512, LDS_BYTES) != hipSuccess || per_cu < 1) { fprintf(stderr, "kernel_launch: occupancy query failed (%d)\n", per_cu); (void)hipGetLastError(); grid = -1; return; }
        grid = cus * per_cu;
        fprintf(stderr, "kernel_launch: grid %d (%d CUs x %d)\n", grid, cus, per_cu);
    }
    if (grid < 0) return;
    Args a{};
    for (int i = 0; i < 19; ++i) a.in[i] = (const float*)d_in[i];
    a.out = (float*)d_out; a.ws = (unsigned char*)d_ws;
#if MK_N_LAUNCHES == 1
    a.ph_lo = 0; a.ph_hi = NPHASE;
    void* kargs[] = {&a};
    hipError_t e = hipLaunchCooperativeKernel((const void*)hymba_fwd, dim3(grid), dim3(512), kargs, LDS_BYTES, stream);
    if (e != hipSuccess) fprintf(stderr, "kernel_launch: cooperative launch failed: %s (grid %d)\n", hipGetErrorString(e), grid);
#else
    for (int p = 0; p < NPHASE; ++p) { a.ph_lo = p; a.ph_hi = p + 1; hipLaunchKernelGGL(hymba_fwd, dim3(grid), dim3(512), LDS_BYTES, stream, a); }
#endif
}
```

```cpp
#include <hip/hip_runtime.h>
#include <hip/hip_cooperative_groups.h>
#include <cstdio>
#include <cstdint>
namespace cg = cooperative_groups;
namespace pg8 {
#define PG8_LAS __attribute__((address_space(3)))
typedef unsigned short bf16_t;
typedef short bf16x8 __attribute__((ext_vector_type(8)));
typedef float f32x4 __attribute__((ext_vector_type(4)));
typedef unsigned u32x4 __attribute__((ext_vector_type(4)));
constexpr int BM = 256, BK = 64, HALF = 128, HTB = HALF * BK * 2  , STAGE_BYTES = 8 * HTB, NXCD = 8, WGM = 8;

__host__ __device__ __forceinline__ int lds_byte(int r, int c) { const int st = (r >> 4) * 2 + (c >> 5), rr = r & 15, cc = c & 31, ob = rr * 64 + cc * 2; return st * 1024 + (ob ^ (((ob >> 9) & 1) << 5)); }
__host__ __device__ __forceinline__ void stage_rc(int b, int& R, int& C) { const int st = b / 1024, sb = b % 1024, swz = sb ^ (((sb >> 9) & 1) << 5); R = (st >> 1) * 16 + swz / 64; C = (st & 1) * 32 + (swz % 64) / 2; }
__host__ __device__ __forceinline__ int perm32(int rho) { const int n = rho >> 4, i = rho & 15; return 8 * (i >> 2) + 4 * n + (i & 3); }

struct Unit { int pm, pn; };
struct Gemm { const bf16_t* A; const bf16_t* Bt; int M, N, K; };

struct StaticOrder {
    int nM, nN, nwg, G, c;
    __host__ __device__ void init(int M, int N, int G_, int c_) { nM = M / BM; nN = N / BM; nwg = nM * nN; G = G_; c = c_; }
    __host__ __device__ bool next(int i, Unit& u) const {
        const long L = (long)i * G + c; if (L >= nwg) return false;
        int wgid = (int)L; { const int q = nwg / NXCD, r = nwg % NXCD, xcd = wgid % NXCD, off = wgid / NXCD; wgid = (xcd < r ? xcd * (q + 1) : r * (q + 1) + (xcd - r) * q) + off; }
        const int nig = WGM * nN, gid = wgid / nig, fm = gid * WGM, gsz = (nM - fm) < WGM ? (nM - fm) : WGM;
        u.pm = fm + ((wgid % nig) % gsz); u.pn = (wgid % nig) / gsz; return true;
    }
    __device__ __forceinline__ void a_ready(const Unit&) const {}
    __device__ __forceinline__ void done(const Unit&) const {}
};
__device__ __forceinline__ unsigned cvt_pk_bf16(float lo, float hi) { unsigned r; asm volatile("v_cvt_pk_bf16_f32 %0, %1, %2" : "=v"(r) : "v"(lo), "v"(hi)); return r; }
template <class Epi, class Sched, bool ALIGN_EPI = false, bool SP2 = false>
__device__ __forceinline__ void gemm_phase(PG8_LAS unsigned char* lds, const Gemm g, const Sched& S, const Epi& E) {
    const int tid = threadIdx.x, wid = __builtin_amdgcn_readfirstlane(tid >> 6), lane = tid & 63, wr = wid >> 2, wc = wid & 3, fr = lane & 15, fq = lane >> 4;
    const int K = g.K, nt = K / BK;
    unsigned voffA[2], voffB[2];
#pragma unroll
    for (int i = 0; i < 2; ++i) { int R, C; stage_rc(tid * 16 + i * 8192, R, C); const int Rb = Epi::PERM ? ((R & ~31) + perm32(R & 31)) : R;
        voffA[i] = (unsigned)(R * K + C) * 2u; voffB[i] = (unsigned)(Rb * K + C) * 2u; }
    const size_t kstep = (size_t)(BK * 2);
    const size_t hstep = (size_t)HALF * K * 2;
    const size_t tstep = 2 * hstep;
    const unsigned ldsw = (unsigned)wid * 1024u;
    const int aoff = lds_byte(wr * 64 + fr, fq * 8), boff = lds_byte(wc * 32 + fr, fq * 8);
#define PG8_SA(b, h) (((b) * 2 + (h)) * HTB)
#define PG8_SB(b, h) ((4 + (b) * 2 + (h)) * HTB)
#define PG8_STAGE(bufoff, gbase, voff) do { _Pragma("unroll") for (int _i = 0; _i < 2; ++_i) \
        __builtin_amdgcn_global_load_lds((const unsigned*)((const char*)(gbase) + (voff)[_i]), (PG8_LAS unsigned*)(lds + (bufoff) + ldsw + _i * 8192), 16, 0, 0); } while (0)
#define PG8_LDA(dst, b, h) do { _Pragma("unroll") for (int m = 0; m < 4; ++m) _Pragma("unroll") for (int k = 0; k < 2; ++k) dst[m][k] = *(const PG8_LAS bf16x8*)(lds + PG8_SA(b, h) + aoff + m * 2048 + k * 1024); } while (0)
#define PG8_LDB(dst, b, h) do { _Pragma("unroll") for (int n = 0; n < 2; ++n) _Pragma("unroll") for (int k = 0; k < 2; ++k) dst[n][k] = *(const PG8_LAS bf16x8*)(lds + PG8_SB(b, h) + boff + n * 2048 + k * 1024); } while (0)
#define PG8_MMA(ai, bj, At, Bt) do { __builtin_amdgcn_s_setprio(1); _Pragma("unroll") for (int m = 0; m < 4; ++m) _Pragma("unroll") for (int n = 0; n < 2; ++n) _Pragma("unroll") for (int k = 0; k < 2; ++k) \
        acc[ai][bj][m][n] = __builtin_amdgcn_mfma_f32_16x16x32_bf16(Bt[n][k], At[m][k], acc[ai][bj][m][n], 0, 0, 0); __builtin_amdgcn_s_setprio(0); } while (0)
#define PG8_WAIT_V(n) asm volatile("s_waitcnt vmcnt(" #n ")" ::: "memory")
#define PG8_WAIT_L(n) asm volatile("s_waitcnt lgkmcnt(" #n ")" ::: "memory")
#define PG8_BAR __builtin_amdgcn_s_barrier()
#define PG8_SCHED __builtin_amdgcn_sched_barrier(0)
    Unit cur, nxt; int ui = 0;
    if (!S.next(0, cur)) return;
    f32x4 acc[2][2][4][2];
#pragma unroll
    for (int a = 0; a < 2; ++a)
#pragma unroll
        for (int b = 0; b < 2; ++b)
#pragma unroll
            for (int m = 0; m < 4; ++m)
#pragma unroll
                for (int n = 0; n < 2; ++n) acc[a][b][m][n] = (f32x4){0.f, 0.f, 0.f, 0.f};
    bf16x8 At[4][2], B0[2][2], B1[2][2];
    const char* cA = (const char*)g.A + (size_t)cur.pm * tstep; const char* cB = (const char*)g.Bt + (size_t)cur.pn * tstep;
    S.a_ready(cur);
    if constexpr (SP2) {
        PG8_STAGE(PG8_SB(0, 0), cB, voffB); PG8_STAGE(PG8_SB(0, 1), cB + hstep, voffB); PG8_STAGE(PG8_SA(0, 0), cA, voffA); PG8_STAGE(PG8_SA(0, 1), cA + hstep, voffA);
        if (wr == 1) PG8_BAR;
        PG8_WAIT_V(2); PG8_BAR;
        PG8_STAGE(PG8_SB(1, 0), cB + kstep, voffB); PG8_STAGE(PG8_SA(1, 0), cA + kstep, voffA); PG8_STAGE(PG8_SB(1, 1), cB + hstep + kstep, voffB);
        PG8_WAIT_V(6); PG8_BAR;
    } else {
        PG8_STAGE(PG8_SB(0, 0), cB, voffB); PG8_STAGE(PG8_SA(0, 0), cA, voffA); PG8_STAGE(PG8_SB(0, 1), cB + hstep, voffB); PG8_STAGE(PG8_SA(0, 1), cA + hstep, voffA);
        if (wr == 1) PG8_BAR;
        PG8_WAIT_V(4); PG8_BAR;
        PG8_STAGE(PG8_SB(1, 0), cB + kstep, voffB); PG8_STAGE(PG8_SA(1, 0), cA + kstep, voffA); PG8_STAGE(PG8_SB(1, 1), cB + hstep + kstep, voffB);
        PG8_WAIT_V(6); PG8_BAR;
    }
    for (;;) {
        const bool has_next = S.next(ui + 1, nxt);
        const char* nA = has_next ? (const char*)g.A + (size_t)nxt.pm * tstep : cA; const char* nB = has_next ? (const char*)g.Bt + (size_t)nxt.pn * tstep : cB;
        for (int t = 0; t < nt; t += 2) {
            const bool last = (t == nt - 2);
            const char* a1 = cA + (size_t)(t + 1) * kstep;
            const char* a2 = last ? nA : cA + (size_t)(t + 2) * kstep; const char* b2 = last ? nB : cB + (size_t)(t + 2) * kstep;
            const char* a3 = a2 + kstep; const char* b3 = b2 + kstep;
            if (last && has_next) S.a_ready(nxt);
            if constexpr (SP2) {
            PG8_LDB(B0, 0, 0); PG8_LDB(B1, 0, 1); PG8_SCHED; PG8_LDA(At, 0, 0); PG8_STAGE(PG8_SA(1, 1), a1 + hstep, voffA);
            PG8_WAIT_V(8); PG8_WAIT_L(0); PG8_BAR; PG8_MMA(0, 0, At, B0); PG8_MMA(0, 1, At, B1); PG8_BAR; PG8_SCHED;
            PG8_LDA(At, 0, 1); PG8_STAGE(PG8_SB(0, 0), b2, voffB); PG8_STAGE(PG8_SB(0, 1), b2 + hstep, voffB); PG8_STAGE(PG8_SA(0, 0), a2, voffA);
            PG8_WAIT_V(8); PG8_WAIT_L(0); PG8_BAR; PG8_MMA(1, 0, At, B0); PG8_MMA(1, 1, At, B1); PG8_BAR; PG8_SCHED;
            PG8_LDB(B0, 1, 0); PG8_LDB(B1, 1, 1); PG8_SCHED; PG8_LDA(At, 1, 0); PG8_STAGE(PG8_SA(0, 1), a2 + hstep, voffA);
            PG8_WAIT_V(8); PG8_WAIT_L(0); PG8_BAR; PG8_MMA(0, 0, At, B0); PG8_MMA(0, 1, At, B1); PG8_BAR; PG8_SCHED;
            PG8_LDA(At, 1, 1); PG8_STAGE(PG8_SB(1, 0), b3, voffB); PG8_STAGE(PG8_SB(1, 1), b3 + hstep, voffB); PG8_STAGE(PG8_SA(1, 0), a3, voffA);
            PG8_WAIT_V(8); PG8_WAIT_L(0); PG8_BAR; PG8_MMA(1, 0, At, B0); PG8_MMA(1, 1, At, B1); PG8_BAR; PG8_SCHED;
            } else {
            PG8_LDB(B0, 0, 0); PG8_SCHED; PG8_LDA(At, 0, 0); PG8_STAGE(PG8_SA(1, 1), a1 + hstep, voffA);
            PG8_WAIT_L(8); PG8_BAR; PG8_WAIT_L(0); PG8_MMA(0, 0, At, B0); PG8_BAR; PG8_SCHED;
            PG8_LDB(B1, 0, 1); PG8_STAGE(PG8_SB(0, 0), b2, voffB);
            PG8_BAR; PG8_WAIT_L(0); PG8_MMA(0, 1, At, B1); PG8_BAR;
            PG8_LDA(At, 0, 1); PG8_STAGE(PG8_SA(0, 0), a2, voffA);
            PG8_BAR; PG8_WAIT_L(0); PG8_MMA(1, 0, At, B0); PG8_BAR; PG8_SCHED;
            PG8_STAGE(PG8_SB(0, 1), b2 + hstep, voffB);
            PG8_WAIT_V(6); PG8_BAR; PG8_MMA(1, 1, At, B1); PG8_BAR;
            PG8_LDB(B0, 1, 0); PG8_SCHED; PG8_LDA(At, 1, 0); PG8_STAGE(PG8_SA(0, 1), a2 + hstep, voffA);
            PG8_WAIT_L(8); PG8_BAR; PG8_WAIT_L(0); PG8_MMA(0, 0, At, B0); PG8_BAR; PG8_SCHED;
            PG8_LDB(B1, 1, 1); PG8_STAGE(PG8_SB(1, 0), b3, voffB);
            PG8_BAR; PG8_WAIT_L(0); PG8_MMA(0, 1, At, B1); PG8_BAR;
            PG8_LDA(At, 1, 1); PG8_STAGE(PG8_SA(1, 0), a3, voffA);
            PG8_BAR; PG8_WAIT_L(0); PG8_MMA(1, 0, At, B0); PG8_BAR; PG8_SCHED;
            PG8_STAGE(PG8_SB(1, 1), b3 + hstep, voffB);
            PG8_WAIT_V(6); PG8_BAR; PG8_MMA(1, 1, At, B1); PG8_BAR;
            }
        }
        if constexpr (ALIGN_EPI) { if (wr == 0) PG8_BAR; }
        if constexpr (!Epi::AFTER_DRAIN) { E(acc, cur, wr, wc, fr, fq); S.done(cur); }
        if (!has_next) break;
#pragma unroll
        for (int a = 0; a < 2; ++a)
#pragma unroll
            for (int b = 0; b < 2; ++b)
#pragma unroll
                for (int m = 0; m < 4; ++m)
#pragma unroll
                    for (int n = 0; n < 2; ++n) acc[a][b][m][n] = (f32x4){0.f, 0.f, 0.f, 0.f};
        cur = nxt; cA = nA; cB = nB; ++ui;
        if constexpr (ALIGN_EPI) { if (wr == 1) PG8_BAR; }
    }
    PG8_WAIT_V(0);
    if constexpr (!ALIGN_EPI) { if (wr == 0) PG8_BAR; }
    PG8_BAR;
    if constexpr (Epi::AFTER_DRAIN) { E.fused(acc, cur, wr, wc, fr, fq, lds, wid, lane); S.done(cur); }
#undef PG8_SA
#undef PG8_SB
#undef PG8_STAGE
#undef PG8_LDA
#undef PG8_LDB
#undef PG8_MMA
#undef PG8_WAIT_V
#undef PG8_WAIT_L
#undef PG8_BAR
#undef PG8_SCHED
}
}

constexpr int D = 2048, NB = 4, SEQ = 2048, NMETA = 16, TP = SEQ + NMETA, MPROMPT = NB * TP, NS = 128, MREAL = MPROMPT + NS, MP = 8448;
constexpr int AW = 1024, NH = 8, NCHUNK = 33, CW = 31, FF = 5632, NIN = 6144, NITEM = NB * NH * NCHUNK;
constexpr float EPS = 1e-6f;
static_assert(MP % 256 == 0 && MP >= MREAL, "row padding");

constexpr size_t MiB = 1u << 20;
constexpr size_t WS_CTL = 0;
constexpr size_t WS_WIN = 1 * MiB, WS_WOUT = 25 * MiB, WS_WGU = 33 * MiB, WS_WD = 77 * MiB;
constexpr size_t WS_XN = 99 * MiB;
constexpr size_t WS_A2 = 132 * MiB;
constexpr size_t WS_QS = 165 * MiB, WS_V = WS_QS + 16896 * 1024, WS_G = WS_V + 16896 * 1024, WS_U = WS_G + 16896 * 1024;
constexpr size_t WS_LF = 231 * MiB;
constexpr size_t WS_SB = 264 * MiB;
constexpr size_t WS_AC = 297 * MiB;
constexpr size_t WS_A4 = 165 * MiB;
constexpr size_t WS_END = 298 * MiB;
static_assert(WS_A4 + (size_t)MP * FF * 2 <= WS_AC && WS_SB + (size_t)NITEM * 32768 <= WS_AC && WS_LF + (size_t)MP * 1024 * 4 <= WS_SB, "ws map");

constexpr int LDS_BYTES = 147456, LDS_MISC = 131072;
constexpr size_t WS_BAR = 256 * 1024, BAR_BYTES = 16384;
#define LAS __attribute__((address_space(3)))
typedef unsigned short bf16;
typedef unsigned v4u __attribute__((ext_vector_type(4)));
typedef unsigned v2u __attribute__((ext_vector_type(2)));
typedef float f32x4 __attribute__((ext_vector_type(4)));
typedef short bf16x8 __attribute__((ext_vector_type(8)));

__device__ __forceinline__ unsigned f2bf(float f) { unsigned u = __builtin_bit_cast(unsigned, f); return (u + 0x7fffu + ((u >> 16) & 1u)) >> 16; }
__device__ __forceinline__ unsigned pk2(float lo, float hi) { return f2bf(lo) | (f2bf(hi) << 16); }
__device__ __forceinline__ float bf2f(unsigned b) { return __builtin_bit_cast(float, b << 16); }
__device__ __forceinline__ float bflo(unsigned w) { return __builtin_bit_cast(float, w << 16); }
__device__ __forceinline__ float bfhi(unsigned w) { return __builtin_bit_cast(float, w & 0xffff0000u); }
__device__ __forceinline__ float sigmoidf_(float x) { return 1.f / (1.f + __expf(-x)); }
__device__ __forceinline__ float siluf_(float x) { return x / (1.f + __expf(-x)); }
__device__ __forceinline__ float wave_sum(float v) {
#pragma unroll
    for (int o = 1; o < 64; o <<= 1) v += __shfl_xor(v, o);
    return v;
}

struct Args { const float* in[19]; float* out; unsigned char* ws; int ph_lo, ph_hi; };
enum { I_XP = 0, I_XS, I_SH, I_SC, I_META, I_GMIX, I_WIN, I_LB, I_HG, I_CWT, I_CB, I_GNG, I_GNB, I_WOUT, I_GFFN, I_WG, I_WU, I_WD, I_GFIN };
constexpr size_t O_YP = 0, O_YS = (size_t)NB * SEQ * D, O_SHP = O_YS + (size_t)NS * D, O_SCP = O_SHP + (size_t)NB * NH * 128 * 128,
                 O_SHS = O_SCP + (size_t)NB * 30 * 1024, O_SCS = O_SHS + (size_t)NS * NH * 128 * 128, O_END = O_SCS + (size_t)NS * 30 * 1024;

struct RowMap { const float* xp; const float* xs; const float* meta; float* out; };
__device__ __forceinline__ const float* src_row(const RowMap& R, int r) {
    if (r >= MPROMPT) return R.xs + (size_t)(r - MPROMPT) * D;
    const int b = r / TP, t = r - b * TP;
    return t < NMETA ? R.meta + (size_t)t * D : R.xp + ((size_t)b * SEQ + (t - NMETA)) * D;
}
__device__ __forceinline__ float* out_row(const RowMap& R, int r) {
    if (r >= MPROMPT) return R.out + O_YS + (size_t)(r - MPROMPT) * D;
    const int b = r / TP, t = r - b * TP;
    return t < NMETA ? nullptr : R.out + O_YP + ((size_t)b * SEQ + (t - NMETA)) * D;
}

using pg8::Unit;
struct EpiIn {
    static constexpr bool PERM = true, AFTER_DRAIN = false;
    bf16* Qs; float* LF; bf16* V; bf16* G; bf16* U; const float* lbv;
    __device__ __forceinline__ void operator()(const f32x4 (&acc)[2][2][4][2], const Unit& u, int wr, int wc, int fr, int fq) const {
        const int row0 = u.pm * 256 + wr * 64 + fr;
        if (u.pn >= 16) {
            const int c0 = (u.pn - 16) * 128 + wc * 32 + 8 * fq;
#pragma unroll
            for (int ai = 0; ai < 2; ++ai)
#pragma unroll
                for (int m = 0; m < 4; ++m) {
                    const size_t row = (size_t)(row0 + ai * 128 + m * 16);
                    float o[8];
#pragma unroll
                    for (int n = 0; n < 2; ++n)
#pragma unroll
                        for (int j = 0; j < 4; ++j) o[n * 4 + j] = acc[ai][0][m][n][j] * sigmoidf_(acc[ai][1][m][n][j]);
                    v4u w; w.x = pg8::cvt_pk_bf16(o[0], o[1]); w.y = pg8::cvt_pk_bf16(o[2], o[3]); w.z = pg8::cvt_pk_bf16(o[4], o[5]); w.w = pg8::cvt_pk_bf16(o[6], o[7]);
                    *(v4u*)(U + row * 1024 + c0) = w;
                }
            return;
        }
        const int kind = u.pn >> 2, cb = (u.pn & 3) * 256 + wc * 32 + 8 * fq;
        if (kind == 1) {
            f32x4 lb[2][2];
#pragma unroll
            for (int bj = 0; bj < 2; ++bj)
#pragma unroll
                for (int n = 0; n < 2; ++n) lb[bj][n] = *(const f32x4*)(lbv + cb + bj * 128 + 4 * n);
#pragma unroll
            for (int ai = 0; ai < 2; ++ai)
#pragma unroll
                for (int m = 0; m < 4; ++m) {
                    const size_t row = (size_t)(row0 + ai * 128 + m * 16);
#pragma unroll
                    for (int bj = 0; bj < 2; ++bj)
#pragma unroll
                        for (int n = 0; n < 2; ++n) {
                            f32x4 o;
#pragma unroll
                            for (int j = 0; j < 4; ++j) { const float l = lb[bj][n][j]; o[j] = __logf(l + (1.f - l) * sigmoidf_(acc[ai][bj][m][n][j])); }
                            *(f32x4*)(LF + row * 1024 + cb + bj * 128 + 4 * n) = o;
                        }
                }
            return;
        }
        bf16* dst = Qs + (size_t)(kind == 0 ? 0 : kind - 1) * ((size_t)MP * 1024);
#pragma unroll
        for (int ai = 0; ai < 2; ++ai)
#pragma unroll
            for (int m = 0; m < 4; ++m) {
                const size_t row = (size_t)(row0 + ai * 128 + m * 16);
#pragma unroll
                for (int bj = 0; bj < 2; ++bj) {
                    float o[8];
#pragma unroll
                    for (int n = 0; n < 2; ++n)
#pragma unroll
                        for (int j = 0; j < 4; ++j) { const float x = acc[ai][bj][m][n][j]; o[n * 4 + j] = (kind == 2) ? x : siluf_(x); }
                    v4u w; w.x = pg8::cvt_pk_bf16(o[0], o[1]); w.y = pg8::cvt_pk_bf16(o[2], o[3]); w.z = pg8::cvt_pk_bf16(o[4], o[5]); w.w = pg8::cvt_pk_bf16(o[6], o[7]);
                    *(v4u*)(dst + row * 1024 + cb + bj * 128) = w;
                }
            }
    }
};

struct EpiOut {
    static constexpr bool PERM = true, AFTER_DRAIN = false;
    RowMap R; bf16* A3; const float* gffn; float* rowss;
    __device__ __forceinline__ void operator()(const f32x4 (&acc)[2][2][4][2], const Unit& u, int wr, int wc, int fr, int fq) const {
        const int row0 = u.pm * 256 + wr * 64 + fr, c0 = u.pn * 256 + wc * 32 + 8 * fq;
        f32x4 gv[2][2];
#pragma unroll
        for (int bj = 0; bj < 2; ++bj)
#pragma unroll
            for (int n = 0; n < 2; ++n) gv[bj][n] = *(const f32x4*)(gffn + c0 + bj * 128 + 4 * n);
#pragma unroll
        for (int ai = 0; ai < 2; ++ai)
#pragma unroll
            for (int m = 0; m < 4; ++m) {
                const int row = row0 + ai * 128 + m * 16;
                float ss = 0.f;
                if (row < MREAL) {
                    const float* src = src_row(R, row) + c0; float* dst = out_row(R, row);
#pragma unroll
                    for (int bj = 0; bj < 2; ++bj) {
                        f32x4 h[2];
#pragma unroll
                        for (int n = 0; n < 2; ++n) { h[n] = acc[ai][bj][m][n] + *(const f32x4*)(src + bj * 128 + 4 * n);
                            ss += (h[n][0] * h[n][0] + h[n][1] * h[n][1]) + (h[n][2] * h[n][2] + h[n][3] * h[n][3]);
                            if (dst) *(f32x4*)(dst + c0 + bj * 128 + 4 * n) = h[n]; }
                        const f32x4 a = h[0] * gv[bj][0], b = h[1] * gv[bj][1];
                        v4u w; w.x = pg8::cvt_pk_bf16(a[0], a[1]); w.y = pg8::cvt_pk_bf16(a[2], a[3]); w.z = pg8::cvt_pk_bf16(b[0], b[1]); w.w = pg8::cvt_pk_bf16(b[2], b[3]);
                        *(v4u*)(A3 + (size_t)row * D + c0 + bj * 128) = w;
                    }
                }
                ss += __shfl_xor(ss, 16); ss += __shfl_xor(ss, 32);
                if (fq == 0 && row < MREAL) atomicAdd(rowss + row, ss);
            }
    }
};

struct EpiGU {
    static constexpr bool PERM = true, AFTER_DRAIN = false;
    const float* rowss; bf16* A4;
    __device__ __forceinline__ void operator()(const f32x4 (&acc)[2][2][4][2], const Unit& u, int wr, int wc, int fr, int fq) const {
        const int row0 = u.pm * 256 + wr * 64 + fr, c0 = u.pn * 128 + wc * 32 + 8 * fq;
#pragma unroll
        for (int ai = 0; ai < 2; ++ai)
#pragma unroll
            for (int m = 0; m < 4; ++m) {
                const int row = row0 + ai * 128 + m * 16;
                const float rstd = rsqrtf(rowss[row] * (1.f / D) + EPS);
                float o[8];
#pragma unroll
                for (int n = 0; n < 2; ++n)
#pragma unroll
                    for (int j = 0; j < 4; ++j) o[n * 4 + j] = siluf_(acc[ai][0][m][n][j] * rstd) * (acc[ai][1][m][n][j] * rstd);
                v4u w; w.x = pg8::cvt_pk_bf16(o[0], o[1]); w.y = pg8::cvt_pk_bf16(o[2], o[3]); w.z = pg8::cvt_pk_bf16(o[4], o[5]); w.w = pg8::cvt_pk_bf16(o[6], o[7]);
                *(v4u*)(A4 + (size_t)row * FF + c0) = w;
            }
    }
};

struct EpiDown {
    static constexpr bool PERM = true, AFTER_DRAIN = false;
    RowMap R; float* rowss;
    __device__ __forceinline__ void operator()(const f32x4 (&acc)[2][2][4][2], const Unit& u, int wr, int wc, int fr, int fq) const {
        const int row0 = u.pm * 256 + wr * 64 + fr, c0 = u.pn * 256 + wc * 32 + 8 * fq;
#pragma unroll
        for (int ai = 0; ai < 2; ++ai)
#pragma unroll
            for (int m = 0; m < 4; ++m) {
                const int row = row0 + ai * 128 + m * 16;
                float ss = 0.f;
                float* dst = row < MREAL ? out_row(R, row) : nullptr;
                if (dst) {
#pragma unroll
                    for (int bj = 0; bj < 2; ++bj)
#pragma unroll
                        for (int n = 0; n < 2; ++n) { f32x4* p = (f32x4*)(dst + c0 + bj * 128 + 4 * n); const f32x4 h = *p + acc[ai][bj][m][n];
                            ss += (h[0] * h[0] + h[1] * h[1]) + (h[2] * h[2] + h[3] * h[3]); *p = h; }
                }
                ss += __shfl_xor(ss, 16); ss += __shfl_xor(ss, 32);
                if (fq == 0 && dst) atomicAdd(rowss + row, ss);
            }
    }
};

__device__ __forceinline__ void p0_transpose_item(const float* W, int K, int N, bf16* WT, int k0, int n0, int drow0, LAS float* scr, int lane) {
#pragma unroll 8
    for (int i = 0; i < 32; ++i) { const int kk = 2 * i + (lane >> 5); scr[kk * 33 + (lane & 31)] = W[(size_t)(k0 + kk) * N + n0 + (lane & 31)]; }
    asm volatile("s_waitcnt lgkmcnt(0)" ::: "memory");
    const int c = lane & 7;
#pragma unroll
    for (int j = 0; j < 4; ++j) { const int n = (lane >> 3) + 8 * j; const LAS float* s = scr + (8 * c) * 33 + n;
        v4u o; o.x = pk2(s[0 * 33], s[1 * 33]); o.y = pk2(s[2 * 33], s[3 * 33]); o.z = pk2(s[4 * 33], s[5 * 33]); o.w = pk2(s[6 * 33], s[7 * 33]);
        *(v4u*)(WT + (size_t)(drow0 + n) * K + k0 + 8 * c) = o; }
    asm volatile("s_waitcnt lgkmcnt(0)" ::: "memory");
}
__device__ __forceinline__ int glu_row(int n0) {
    if (n0 < 4096) return n0;
    if (n0 < 5120) { const int c = n0 - 4096; return 4096 + (c >> 7) * 256 + (c & 127); }
    const int c = n0 - 5120; return 4096 + (c >> 7) * 256 + 128 + (c & 127);
}
__device__ __forceinline__ void p0_prologue(const Args& a, LAS unsigned char* lds, int tid, int lane, int wave) {
    unsigned char* ws = a.ws;
    LAS float* scr = (LAS float*)(lds + wave * 16384);
    const int gw = blockIdx.x * 8 + wave, NGW = gridDim.x * 8;
    constexpr int I_IN = (D / 64) * (NIN / 32), I_OUT = (D / 64) * (D / 32), I_G = (D / 64) * (FF / 32), I_DN = (FF / 64) * (D / 32);
    constexpr int NITEMS = I_IN + I_OUT + 2 * I_G + I_DN;
    for (int it = gw; it < NITEMS; it += NGW) {
        int r = it;
        if (r < I_IN) { const int nblk = NIN / 32, kb = r / nblk, nb = r % nblk; p0_transpose_item(a.in[I_WIN], D, NIN, (bf16*)(ws + WS_WIN), 64 * kb, 32 * nb, glu_row(32 * nb), scr, lane); continue; } r -= I_IN;
        if (r < I_OUT) { const int nblk = D / 32, kb = r / nblk, nb = r % nblk; p0_transpose_item(a.in[I_WOUT], D, D, (bf16*)(ws + WS_WOUT), 64 * kb, 32 * nb, 32 * nb, scr, lane); continue; } r -= I_OUT;
        if (r < I_G) { const int nblk = FF / 32, kb = r / nblk, nb = r % nblk, n0 = 32 * nb; p0_transpose_item(a.in[I_WG], D, FF, (bf16*)(ws + WS_WGU), 64 * kb, n0, (n0 >> 7) * 256 + (n0 & 127), scr, lane); continue; } r -= I_G;
        if (r < I_G) { const int nblk = FF / 32, kb = r / nblk, nb = r % nblk, n0 = 32 * nb; p0_transpose_item(a.in[I_WU], D, FF, (bf16*)(ws + WS_WGU), 64 * kb, n0, (n0 >> 7) * 256 + 128 + (n0 & 127), scr, lane); continue; } r -= I_G;
        { const int nblk = D / 32, kb = r / nblk, nb = r % nblk; p0_transpose_item(a.in[I_WD], FF, D, (bf16*)(ws + WS_WD), 64 * kb, 32 * nb, 32 * nb, scr, lane); }
    }
    RowMap R{a.in[I_XP], a.in[I_XS], a.in[I_META], a.out};
    const float* gm = a.in[I_GMIX]; bf16* XN = (bf16*)(ws + WS_XN);
    for (int m = gw; m < MP; m += NGW) {
        v4u* o = (v4u*)(XN + (size_t)m * D) + lane;
        if (m >= MREAL) {
#pragma unroll
            for (int j = 0; j < 4; ++j) o[64 * j] = (v4u){0u, 0u, 0u, 0u};
            continue; }
        const f32x4* xr = (const f32x4*)src_row(R, m);
        f32x4 v[8]; float s = 0.f;
#pragma unroll
        for (int j = 0; j < 4; ++j) { v[2 * j] = xr[2 * lane + 128 * j]; v[2 * j + 1] = xr[2 * lane + 128 * j + 1]; }
#pragma unroll
        for (int j = 0; j < 8; ++j) s += (v[j][0] * v[j][0] + v[j][1] * v[j][1]) + (v[j][2] * v[j][2] + v[j][3] * v[j][3]);
        const float rstd = rsqrtf(wave_sum(s) * (1.f / D) + EPS);
#pragma unroll
        for (int j = 0; j < 4; ++j) { const f32x4 g0 = ((const f32x4*)gm)[2 * lane + 128 * j], g1 = ((const f32x4*)gm)[2 * lane + 128 * j + 1];
            const f32x4 a0 = v[2 * j] * rstd * g0, a1 = v[2 * j + 1] * rstd * g1;
            v4u w; w.x = pk2(a0[0], a0[1]); w.y = pk2(a0[2], a0[3]); w.z = pk2(a1[0], a1[1]); w.w = pk2(a1[2], a1[3]);
            o[64 * j] = w; }
    }
    float* ctl = (float*)(ws + WS_CTL);
    for (int i = blockIdx.x * 512 + tid; i < AW; i += gridDim.x * 512) { const float l0 = a.in[I_LB][i], l1 = a.in[I_LB][AW + i]; const float mx = fmaxf(l0, l1);
        const float e0 = __expf(l0 - mx), e1 = __expf(l1 - mx); ctl[i] = e0 / (e0 + e1); }
    for (int i = blockIdx.x * 512 + tid; i < MP; i += gridDim.x * 512) { ctl[16384 + i] = 0.f; ctl[32768 + i] = 0.f; }
}

constexpr int L_KT2 = 2048, L_TOT = 0, L_QP = 2048, L_QT = 19456, L_KT = 36864, L_VT = 54272, L_ST = 72704, L_PM = 107520, L_OB = 19456;
constexpr int RS_K = 136, RS_S = 72;
__device__ __forceinline__ void chunk_rows(int it, int& rowbase, int& nvalid, int& col0) {
    const int c = it % NCHUNK, bh = it / NCHUNK, h = bh & 7, b = bh >> 3;
    col0 = h * 128;
    if (c == 0) { rowbase = b * TP; nvalid = NMETA; } else { rowbase = b * TP + NMETA + (c - 1) * 64; nvalid = 64; }
}
__device__ __forceinline__ bf16x8 lds_frag(const LAS unsigned char* p) { return *(const LAS bf16x8*)p; }

__device__ __forceinline__ void hgrn_local(const Args& a, LAS unsigned char* lds, int tid, int lane, int wave) {
    unsigned char* ws = a.ws;
    const float* LF = (const float*)(ws + WS_LF); const bf16* V = (const bf16*)(ws + WS_V);
    bf16* SB = (bf16*)(ws + WS_SB); float* AC = (float*)(ws + WS_AC);
    LAS float* tot = (LAS float*)(lds + L_TOT);
    const int c_ = tid & 127, seg = tid >> 7;
    for (int it = blockIdx.x; it < NITEM; it += gridDim.x) {
        int rowbase, nvalid, col0; chunk_rows(it, rowbase, nvalid, col0);
        float lf[16], pre[16];
#pragma unroll
        for (int i = 0; i < 16; ++i) { const int s = seg * 16 + i; lf[i] = s < nvalid ? LF[(size_t)(rowbase + s) * 1024 + col0 + c_] : 0.f; }
        float run = 0.f;
#pragma unroll
        for (int i = 0; i < 16; ++i) { run += lf[i]; pre[i] = run; }
        tot[seg * 128 + c_] = run;
        unsigned vv[8];
#pragma unroll
        for (int i = 0; i < 8; ++i) { const int s = seg * 16 + 2 * i;
            const unsigned lo = s < nvalid ? V[(size_t)(rowbase + s) * 1024 + col0 + c_] : 0u, hi = s + 1 < nvalid ? V[(size_t)(rowbase + s + 1) * 1024 + col0 + c_] : 0u;
            vv[i] = lo | (hi << 16); }
        __syncthreads();
        const float t0 = tot[c_], t1 = tot[128 + c_], t2 = tot[256 + c_], t3 = tot[384 + c_];
        const float off = seg == 0 ? 0.f : (seg == 1 ? t0 : (seg == 2 ? t0 + t1 : t0 + t1 + t2)), blast = (t0 + t1) + (t2 + t3);
        unsigned kk[8];
#pragma unroll
        for (int i = 0; i < 8; ++i) {
            const float k0 = (1.f - __expf(lf[2 * i])) * __expf(blast - (off + pre[2 * i])), k1 = (1.f - __expf(lf[2 * i + 1])) * __expf(blast - (off + pre[2 * i + 1]));
            kk[i] = pk2(k0, k1); }
        LAS unsigned char* kt = lds + L_KT2 + c_ * (RS_S * 2) + seg * 32;
        LAS unsigned char* vt = lds + L_VT + c_ * (RS_S * 2) + seg * 32;
        *(LAS v4u*)kt = (v4u){kk[0], kk[1], kk[2], kk[3]}; *(LAS v4u*)(kt + 16) = (v4u){kk[4], kk[5], kk[6], kk[7]};
        *(LAS v4u*)vt = (v4u){vv[0], vv[1], vv[2], vv[3]}; *(LAS v4u*)(vt + 16) = (v4u){vv[4], vv[5], vv[6], vv[7]};
        if (seg == 0) AC[(size_t)it * 128 + c_] = __expf(blast);
        __syncthreads();
        const int r = lane & 15, q = lane >> 4;
        f32x4 acc[8];
#pragma unroll
        for (int n = 0; n < 8; ++n) acc[n] = (f32x4){0.f, 0.f, 0.f, 0.f};
#pragma unroll
        for (int ks = 0; ks < 2; ++ks) {
            const bf16x8 af = lds_frag(lds + L_KT2 + (wave * 16 + r) * (RS_S * 2) + (ks * 32 + q * 8) * 2);
#pragma unroll
            for (int n = 0; n < 8; ++n) { const bf16x8 bfm = lds_frag(lds + L_VT + (n * 16 + r) * (RS_S * 2) + (ks * 32 + q * 8) * 2);
                acc[n] = __builtin_amdgcn_mfma_f32_16x16x32_bf16(af, bfm, acc[n], 0, 0, 0); }
        }
        bf16* bt = SB + (size_t)it * 16384;
#pragma unroll
        for (int n = 0; n < 8; ++n) { v2u w; w.x = pk2(acc[n][0], acc[n][1]); w.y = pk2(acc[n][2], acc[n][3]);
            *(v2u*)(bt + (n * 16 + r) * 128 + wave * 16 + 4 * q) = w; }
        __syncthreads();
    }
}

__device__ __forceinline__ void hgrn_scan(const Args& a, int tid) {
    unsigned char* ws = a.ws; bf16* SB = (bf16*)(ws + WS_SB); const float* AC = (const float*)(ws + WS_AC);
    float* outS = a.out + O_SHP;
    for (int g = blockIdx.x * 512 + tid; g < NB * NH * 128 * 32; g += gridDim.x * 512) {
        const int bh = g >> 12, rem = g & 4095, v = rem >> 5, k4 = rem & 31;
        float S0 = 0.f, S1 = 0.f, S2 = 0.f, S3 = 0.f;
#pragma unroll 3
        for (int c = 0; c < NCHUNK; ++c) {
            const size_t it = (size_t)bh * NCHUNK + c;
            const f32x4 dec = *(const f32x4*)(AC + it * 128 + 4 * k4);
            v2u* p = (v2u*)(SB + it * 16384 + v * 128 + 4 * k4);
            const v2u bw = *p;
            v2u sw; sw.x = pk2(S0, S1); sw.y = pk2(S2, S3); *p = sw;
            S0 = dec[0] * S0 + bflo(bw.x); S1 = dec[1] * S1 + bfhi(bw.x); S2 = dec[2] * S2 + bflo(bw.y); S3 = dec[3] * S3 + bfhi(bw.y);
        }
        float* o = outS + ((size_t)bh * 128 + 4 * k4) * 128 + v;
        o[0] = S0; o[128] = S1; o[256] = S2; o[384] = S3;
    }
}

__device__ __forceinline__ void hgrn_out(const Args& a, LAS unsigned char* lds, int tid, int lane, int wave) {
    unsigned char* ws = a.ws;
    const float* LF = (const float*)(ws + WS_LF); const bf16* V = (const bf16*)(ws + WS_V); const bf16* Qs = (const bf16*)(ws + WS_QS); const bf16* G = (const bf16*)(ws + WS_G);
    const bf16* SB = (const bf16*)(ws + WS_SB); bf16* A2 = (bf16*)(ws + WS_A2); const float* hg = a.in[I_HG];
    LAS float* tot = (LAS float*)(lds + L_TOT);
    const int c_ = tid & 127, seg = tid >> 7;
    for (int it = blockIdx.x; it < NITEM; it += gridDim.x) {
        int rowbase, nvalid, col0; chunk_rows(it, rowbase, nvalid, col0);
        float lf[16], pre[16];
#pragma unroll
        for (int i = 0; i < 16; ++i) { const int s = seg * 16 + i; lf[i] = s < nvalid ? LF[(size_t)(rowbase + s) * 1024 + col0 + c_] : 0.f; }
        float run = 0.f;
#pragma unroll
        for (int i = 0; i < 16; ++i) { run += lf[i]; pre[i] = run; }
        tot[seg * 128 + c_] = run;
        unsigned vv[8];
#pragma unroll
        for (int i = 0; i < 8; ++i) { const int s = seg * 16 + 2 * i;
            const unsigned lo = s < nvalid ? V[(size_t)(rowbase + s) * 1024 + col0 + c_] : 0u, hi = s + 1 < nvalid ? V[(size_t)(rowbase + s + 1) * 1024 + col0 + c_] : 0u;
            vv[i] = lo | (hi << 16); }
        { LAS unsigned char* vt = lds + L_VT + c_ * (RS_S * 2) + seg * 32;
          *(LAS v4u*)vt = (v4u){vv[0], vv[1], vv[2], vv[3]}; *(LAS v4u*)(vt + 16) = (v4u){vv[4], vv[5], vv[6], vv[7]}; }
        { const v4u* sp = (const v4u*)(SB + (size_t)it * 16384);
#pragma unroll
          for (int j = 0; j < 4; ++j) { const int id = tid + 512 * j, v = id >> 4, kc = id & 15; *(LAS v4u*)(lds + L_ST + v * (RS_K * 2) + kc * 16) = sp[id]; } }
        float qv[16];
#pragma unroll
        for (int i = 0; i < 16; ++i) { const int s = seg * 16 + i; qv[i] = s < nvalid ? bf2f(Qs[(size_t)(rowbase + s) * 1024 + col0 + c_]) : 0.f; }
        __syncthreads();
        const float t0 = tot[c_], t1 = tot[128 + c_], t2 = tot[256 + c_];
        const float off = seg == 0 ? 0.f : (seg == 1 ? t0 : (seg == 2 ? t0 + t1 : t0 + t1 + t2)), bref = t0 + t1;
#pragma unroll
        for (int i = 0; i < 16; ++i) {
            const int s = seg * 16 + i; const float b = off + pre[i];
            const float qp = qv[i] * __expf(b), qt = qv[i] * __expf(fminf(b - bref, 80.f)), kt = (1.f - __expf(lf[i])) * __expf(fminf(bref - b, 80.f));
            ((LAS bf16*)(lds + L_QP))[s * RS_K + c_] = (bf16)f2bf(qp);
            ((LAS bf16*)(lds + L_QT))[s * RS_K + c_] = (bf16)f2bf(qt);
            ((LAS bf16*)(lds + L_KT))[s * RS_K + c_] = (bf16)f2bf(kt);
        }
        __syncthreads();
        const int r = lane & 15, q = lane >> 4;
        {
            const int sb = wave & 3, tb0 = (wave >> 2) * 2;
            f32x4 sc[2] = {(f32x4){0.f, 0.f, 0.f, 0.f}, (f32x4){0.f, 0.f, 0.f, 0.f}};
#pragma unroll
            for (int ks = 0; ks < 4; ++ks) {
                const bf16x8 af = lds_frag(lds + L_KT + (sb * 16 + r) * (RS_K * 2) + (ks * 32 + q * 8) * 2);
#pragma unroll
                for (int n = 0; n < 2; ++n) { const bf16x8 bfm = lds_frag(lds + L_QT + ((tb0 + n) * 16 + r) * (RS_K * 2) + (ks * 32 + q * 8) * 2);
                    sc[n] = __builtin_amdgcn_mfma_f32_16x16x32_bf16(af, bfm, sc[n], 0, 0, 0); }
            }
#pragma unroll
            for (int n = 0; n < 2; ++n) { const int t = (tb0 + n) * 16 + r, s0 = sb * 16 + 4 * q;
                const float p0 = s0 <= t ? sc[n][0] : 0.f, p1 = s0 + 1 <= t ? sc[n][1] : 0.f, p2 = s0 + 2 <= t ? sc[n][2] : 0.f, p3 = s0 + 3 <= t ? sc[n][3] : 0.f;
                v2u w; w.x = pk2(p0, p1); w.y = pk2(p2, p3);
                *(LAS v2u*)(lds + L_PM + t * (RS_S * 2) + s0 * 2) = w; }
        }
        __syncthreads();
        {
            const int tb = wave & 3, nv0 = (wave >> 2) * 4;
            f32x4 oc[4];
#pragma unroll
            for (int n = 0; n < 4; ++n) oc[n] = (f32x4){0.f, 0.f, 0.f, 0.f};
#pragma unroll
            for (int ks = 0; ks < 2; ++ks) {
                const bf16x8 af = lds_frag(lds + L_PM + (tb * 16 + r) * (RS_S * 2) + (ks * 32 + q * 8) * 2);
#pragma unroll
                for (int n = 0; n < 4; ++n) { const bf16x8 bfm = lds_frag(lds + L_VT + ((nv0 + n) * 16 + r) * (RS_S * 2) + (ks * 32 + q * 8) * 2);
                    oc[n] = __builtin_amdgcn_mfma_f32_16x16x32_bf16(af, bfm, oc[n], 0, 0, 0); }
            }
#pragma unroll
            for (int ks = 0; ks < 4; ++ks) {
                const bf16x8 af = lds_frag(lds + L_QP + (tb * 16 + r) * (RS_K * 2) + (ks * 32 + q * 8) * 2);
#pragma unroll
                for (int n = 0; n < 4; ++n) { const bf16x8 bfm = lds_frag(lds + L_ST + ((nv0 + n) * 16 + r) * (RS_K * 2) + (ks * 32 + q * 8) * 2);
                    oc[n] = __builtin_amdgcn_mfma_f32_16x16x32_bf16(af, bfm, oc[n], 0, 0, 0); }
            }
#pragma unroll
            for (int n = 0; n < 4; ++n)
#pragma unroll
                for (int j = 0; j < 4; ++j) ((LAS float*)(lds + L_OB))[(tb * 16 + 4 * q + j) * 132 + (nv0 + n) * 16 + r] = oc[n][j];
        }
        __syncthreads();
        {
            const int t = tid >> 3, part = tid & 7, v0 = part * 16;
            const LAS f32x4* op = (const LAS f32x4*)(lds + L_OB + (t * 132 + v0) * 4);
            f32x4 o4[4]; float ss = 0.f;
#pragma unroll
            for (int j = 0; j < 4; ++j) { o4[j] = op[j]; ss += (o4[j][0] * o4[j][0] + o4[j][1] * o4[j][1]) + (o4[j][2] * o4[j][2] + o4[j][3] * o4[j][3]); }
            ss += __shfl_xor(ss, 1); ss += __shfl_xor(ss, 2); ss += __shfl_xor(ss, 4);
            const float rstd = rsqrtf(ss * (1.f / 128.f) + EPS);
            if (t < nvalid) {
                const size_t row = (size_t)(rowbase + t);
                const v4u* gp = (const v4u*)(G + row * 1024 + col0 + v0); const f32x4* hp = (const f32x4*)(hg + col0 + v0);
                v4u* dst = (v4u*)(A2 + row * D + col0 + v0);
#pragma unroll
                for (int hhalf = 0; hhalf < 2; ++hhalf) { const v4u gw = gp[hhalf]; const f32x4 h0 = hp[2 * hhalf], h1 = hp[2 * hhalf + 1]; const f32x4 x0 = o4[2 * hhalf] * rstd * h0, x1 = o4[2 * hhalf + 1] * rstd * h1;
                    v4u w; w.x = pk2(x0[0] * bflo(gw.x), x0[1] * bfhi(gw.x)); w.y = pk2(x0[2] * bflo(gw.y), x0[3] * bfhi(gw.y));
                    w.z = pk2(x1[0] * bflo(gw.z), x1[1] * bfhi(gw.z)); w.w = pk2(x1[2] * bflo(gw.w), x1[3] * bfhi(gw.w));
                    dst[hhalf] = w; }
            }
        }
        __syncthreads();
    }
}

__device__ __forceinline__ void conv_prompt(const Args& a, LAS unsigned char* lds, int tid, int lane, int wave) {
    unsigned char* ws = a.ws; const bf16* U = (const bf16*)(ws + WS_U); bf16* A2 = (bf16*)(ws + WS_A2);
    const float* cw = a.in[I_CWT]; const float* cb = a.in[I_CB]; const float* gng = a.in[I_GNG]; const float* gnb = a.in[I_GNB];
    LAS float* red = (LAS float*)lds;
    constexpr int NTT = (TP + 31) / 32;
    for (int it = blockIdx.x; it < NB * NTT * 4; it += gridDim.x) {
        const int cbk = it & 3, tt = (it >> 2) % NTT, b = (it >> 2) / NTT;
        const int ch = cbk * 256 + (tid & 255), t0 = tt * 32 + (tid >> 8) * 16;
        float w[CW];
#pragma unroll
        for (int j = 0; j < CW; ++j) w[j] = cw[j * 1024 + ch];
        float uw[46];
#pragma unroll
        for (int j = 0; j < 46; ++j) { const int tok = t0 - 30 + j; uw[j] = (tok >= 0 && tok < TP) ? bf2f(U[(size_t)(b * TP + tok) * 1024 + ch]) : 0.f; }
        const float bias = cb[ch];
        float c[16];
#pragma unroll
        for (int i = 0; i < 16; ++i) { float s = bias;
#pragma unroll
            for (int j = 0; j < CW; ++j) s += w[j] * uw[i + j];
            c[i] = s; }
#pragma unroll
        for (int i = 0; i < 16; ++i) { const float s1 = wave_sum(c[i]), s2 = wave_sum(c[i] * c[i]); if (lane == 0) { red[(wave * 16 + i) * 2] = s1; red[(wave * 16 + i) * 2 + 1] = s2; } }
        __syncthreads();
        const float gg = gng[ch], gb = gnb[ch];
#pragma unroll
        for (int i = 0; i < 16; ++i) {
            const float s1 = red[(wave * 16 + i) * 2] + red[((wave ^ 1) * 16 + i) * 2], s2 = red[(wave * 16 + i) * 2 + 1] + red[((wave ^ 1) * 16 + i) * 2 + 1];
            const float mu = s1 * (1.f / 128.f), var = fmaxf(s2 * (1.f / 128.f) - mu * mu, 0.f);
            const float cn = (c[i] - mu) * rsqrtf(var + EPS) * gg + gb;
            const int tok = t0 + i;
            if (tok < TP) A2[(size_t)(b * TP + tok) * D + 1024 + ch] = (bf16)f2bf(siluf_(cn));
        }
        __syncthreads();
    }
    float* o = a.out + O_SCP;
    for (int i = blockIdx.x * 512 + tid; i < NB * 30 * 1024; i += gridDim.x * 512) { const int ch = i & 1023, j = (i >> 10) % 30, b = (i >> 10) / 30;
        o[i] = bf2f(U[(size_t)(b * TP + TP - 30 + j) * 1024 + ch]); }
}
__device__ __forceinline__ void conv_sample(const Args& a, LAS unsigned char* lds, int tid, int lane, int wave) {
    unsigned char* ws = a.ws; const bf16* U = (const bf16*)(ws + WS_U); bf16* A2 = (bf16*)(ws + WS_A2);
    const float* cw = a.in[I_CWT]; const float* cb = a.in[I_CB]; const float* gng = a.in[I_GNG]; const float* gnb = a.in[I_GNB];
    const float* sc = a.in[I_SC]; float* o = a.out + O_SCS;
    LAS float* red = (LAS float*)lds;
    for (int it = blockIdx.x; it < NS * 2; it += gridDim.x) {
        const int sb = it >> 1, ch = (it & 1) * 512 + tid;
        const float* st = sc + (size_t)sb * 30 * 1024 + ch; float* ot = o + (size_t)sb * 30 * 1024 + ch;
        const float un = bf2f(U[(size_t)(MPROMPT + sb) * 1024 + ch]);
        float s = cb[ch];
#pragma unroll
        for (int j = 0; j < 30; ++j) { const float x = st[j * 1024]; s += cw[j * 1024 + ch] * x; if (j >= 1) ot[(j - 1) * 1024] = x; }
        s += cw[30 * 1024 + ch] * un; ot[29 * 1024] = un;
        const float s1 = wave_sum(s), s2 = wave_sum(s * s);
        if (lane == 0) { red[wave * 2] = s1; red[wave * 2 + 1] = s2; }
        __syncthreads();
        const float a1 = red[wave * 2] + red[(wave ^ 1) * 2], a2 = red[wave * 2 + 1] + red[(wave ^ 1) * 2 + 1];
        const float mu = a1 * (1.f / 128.f), var = fmaxf(a2 * (1.f / 128.f) - mu * mu, 0.f);
        const float cn = (s - mu) * rsqrtf(var + EPS) * gng[ch] + gnb[ch];
        A2[(size_t)(MPROMPT + sb) * D + 1024 + ch] = (bf16)f2bf(siluf_(cn));
        __syncthreads();
    }
}
__device__ __forceinline__ void hgrn_sample(const Args& a, LAS unsigned char* lds, int tid, int lane, int wave) {
    unsigned char* ws = a.ws;
    const float* LF = (const float*)(ws + WS_LF); const bf16* V = (const bf16*)(ws + WS_V); const bf16* Qs = (const bf16*)(ws + WS_QS); const bf16* G = (const bf16*)(ws + WS_G);
    bf16* A2 = (bf16*)(ws + WS_A2); const float* hg = a.in[I_HG]; const float* S0 = a.in[I_SH]; float* So = a.out + O_SHS;
    LAS float* qf = (LAS float*)lds;
    LAS float* red = (LAS float*)(lds + 4096);
    LAS float* r2 = (LAS float*)(lds + 4096 + 8192);
    for (int it = blockIdx.x; it < NS * NH; it += gridDim.x) {
        const int sb = it >> 3, h = it & 7; const size_t row = (size_t)(MPROMPT + sb);
        if (tid < 128) { const size_t idx = row * 1024 + h * 128 + tid; const float f = __expf(LF[idx]);
            qf[tid] = bf2f(Qs[idx]); qf[128 + tid] = f; qf[256 + tid] = 1.f - f; qf[384 + tid] = bf2f(V[idx]); }
        __syncthreads();
        const int v4 = tid & 31, ks = tid >> 5;
        const f32x4 vv = *(const LAS f32x4*)(qf + 384 + 4 * v4);
        const float* sp = S0 + (size_t)it * 16384; float* so = So + (size_t)it * 16384;
        f32x4 o = (f32x4){0.f, 0.f, 0.f, 0.f};
#pragma unroll
        for (int i = 0; i < 8; ++i) { const int k = ks * 8 + i; const f32x4 s = *(const f32x4*)(sp + k * 128 + 4 * v4);
            const f32x4 sn = s * qf[128 + k] + vv * qf[256 + k]; *(f32x4*)(so + k * 128 + 4 * v4) = sn; o += sn * qf[k]; }
        *(LAS f32x4*)(red + ks * 128 + 4 * v4) = o;
        __syncthreads();
        float ov = 0.f;
        if (tid < 128) {
#pragma unroll
            for (int j = 0; j < 16; ++j) ov += red[j * 128 + tid];
            const float ss = wave_sum(ov * ov); if (lane == 0) r2[wave] = ss; }
        __syncthreads();
        if (tid < 128) { const float rstd = rsqrtf((r2[0] + r2[1]) * (1.f / 128.f) + EPS); const size_t idx = row * 1024 + h * 128 + tid;
            A2[row * D + h * 128 + tid] = (bf16)f2bf(ov * rstd * hg[h * 128 + tid] * bf2f(G[idx])); }
        __syncthreads();
    }
}

__device__ __forceinline__ void final_norm(const Args& a, int lane, int wave) {
    RowMap R{a.in[I_XP], a.in[I_XS], a.in[I_META], a.out};
    const float* rowss = (const float*)(a.ws + WS_CTL) + 32768; const f32x4* g = (const f32x4*)a.in[I_GFIN];
    for (int m = blockIdx.x * 8 + wave; m < MREAL; m += gridDim.x * 8) {
        float* dst = out_row(R, m); if (!dst) continue;
        const float rstd = rsqrtf(rowss[m] * (1.f / D) + EPS);
        f32x4* p = (f32x4*)dst + lane;
#pragma unroll
        for (int j = 0; j < 8; ++j) p[64 * j] = p[64 * j] * rstd * g[lane + 64 * j];
    }
}

#define XB_TMO      128
#define XB_XCNT(j)  (256  + 64 * (j))
#define XB_XSUB(j)  (1280 + 64 * (j))
#define XB_XGEN(j)  (2304 + 64 * (j))
#define XB_TOP      3328
#define XB_TOPGEN   3392
#define XCD_BAR_WORDS 3456
#define XB_SPIN_CAP (1u << 18)

__device__ __forceinline__ unsigned xb_ld(unsigned* p)              { return __hip_atomic_load(p, __ATOMIC_RELAXED, __HIP_MEMORY_SCOPE_AGENT); }
__device__ __forceinline__ unsigned xb_add(unsigned* p, unsigned v) { return __hip_atomic_fetch_add(p, v, __ATOMIC_RELAXED, __HIP_MEMORY_SCOPE_AGENT); }
__device__ __forceinline__ unsigned xb_xcc_id() { return (unsigned)__builtin_amdgcn_s_getreg((3 << 11) | 20) & 0xFu; }
#define XB_SPIN(cond, bar) do { unsigned _sp = 0; while (cond) { __builtin_amdgcn_s_sleep(1); \
    if ((++_sp & 255u) == 0u) { if (xb_ld(&(bar)[XB_TMO])) break; if (_sp > XB_SPIN_CAP) { atomicAdd(&(bar)[XB_TMO], 1u); break; } } } } while (0)

struct XcdBarrier {
    unsigned* bar; unsigned x;
    volatile LAS unsigned* st;
};

__device__ __forceinline__ XcdBarrier xcd_barrier_post(unsigned* bar, volatile LAS unsigned* st) {
    XcdBarrier b; b.bar = bar; b.x = xb_xcc_id(); b.st = st;
    if (threadIdx.x == 0) (void)xb_add(&bar[XB_XCNT(b.x)], 1u);
    return b;
}
__device__ __forceinline__ void xcd_barrier_complete(unsigned* bar, unsigned x, unsigned& nloc, unsigned& nx) {
    const unsigned G = gridDim.x * gridDim.y * gridDim.z;
    unsigned sum, cnt, mine, sp = 0u;
    for (;;) {
        sum = 0u; cnt = 0u; mine = 0u;
#pragma unroll
        for (unsigned j = 0; j < 16; ++j) { const unsigned c = xb_ld(&bar[XB_XCNT(j)]); sum += c; cnt += (c > 0u) ? 1u : 0u; mine = (j == x) ? c : mine; }
        if (sum == G) break;
        __builtin_amdgcn_s_sleep(1);
        if ((++sp & 255u) == 0u) { if (xb_ld(&bar[XB_TMO])) break; if (sp > XB_SPIN_CAP) { atomicAdd(&bar[XB_TMO], 1u); break; } }
    }
    nloc = mine > 0u ? mine : 1u; nx = cnt > 0u ? cnt : 1u;
}

__device__ __forceinline__ void xcd_barrier(const XcdBarrier& b) {
    asm volatile("s_waitcnt vmcnt(0)" ::: "memory");
    __syncthreads();
    if (threadIdx.x == 0) {
        unsigned* bar = b.bar;
        __builtin_amdgcn_s_waitcnt(0);
        unsigned nloc = b.st[0], nx = b.st[1];
        if (nloc == 0u) { xcd_barrier_complete(bar, b.x, nloc, nx); b.st[0] = nloc; b.st[1] = nx; }
        const unsigned old = xb_add(&bar[XB_XSUB(b.x)], 1u);
        const unsigned gen = old / nloc;
        if (old + 1u == (gen + 1u) * nloc) {
            __builtin_amdgcn_fence(__ATOMIC_RELEASE, "agent");
            asm volatile("s_waitcnt vmcnt(0)" ::: "memory");
            const unsigned og = xb_add(&bar[XB_TOP], 1u);
            const unsigned tg = og / nx;
            if (og + 1u == (tg + 1u) * nx) xb_add(&bar[XB_TOPGEN], 1u);
            else XB_SPIN(xb_ld(&bar[XB_TOPGEN]) == tg, bar);
            __builtin_amdgcn_fence(__ATOMIC_ACQUIRE, "agent");
            xb_add(&bar[XB_XGEN(b.x)], 1u);
            asm volatile("s_waitcnt vmcnt(0)" ::: "memory");
        } else {
            XB_SPIN(xb_ld(&bar[XB_XGEN(b.x)]) == gen, bar);
            __builtin_amdgcn_fence(__ATOMIC_ACQUIRE, "agent");
            asm volatile("s_waitcnt vmcnt(0)" ::: "memory");
        }
    }
    __syncthreads();
}

constexpr int NPHASE = 9;
#ifndef REP_P0
#define REP_P0 1
#endif
#ifndef REP_G1
#define REP_G1 1
#endif
#ifndef REP_P2
#define REP_P2 1
#endif
#ifndef REP_SYNC
#define REP_SYNC 1
#endif
__global__ void __launch_bounds__(512, 2) hymba_fwd(Args args) {
    extern __shared__ __attribute__((aligned(16))) unsigned char lds_raw[];
    LAS unsigned char* lds = (LAS unsigned char*)lds_raw;
    cg::grid_group grid = cg::this_grid();
    const int tid = threadIdx.x, lane = tid & 63, wave = __builtin_amdgcn_readfirstlane(tid >> 6);
    unsigned char* ws = args.ws;
    const int lo = args.ph_lo, hi = args.ph_hi;
#define IN(k) (lo <= (k) && (k) < hi)
#define SEAM(k) do { if (IN(k) && IN((k) + 1)) { for (int rep_ = 0; rep_ < REP_SYNC; ++rep_) xcd_barrier(bar); } } while (0)
    RowMap R{args.in[I_XP], args.in[I_XS], args.in[I_META], args.out};
    if (lo < 0) grid.sync();
    if (tid < 64) ((LAS unsigned*)(lds + LDS_MISC))[tid] = 0u;
    __syncthreads();
    XcdBarrier bar; bar.bar = (unsigned*)(ws + WS_BAR); bar.x = 0; bar.st = nullptr;
    if (hi - lo > 1) bar = xcd_barrier_post((unsigned*)(ws + WS_BAR), (volatile LAS unsigned*)(lds + LDS_MISC) + 8);
    if (IN(0)) { for (int rep = 0; rep < REP_P0; ++rep) p0_prologue(args, lds, tid, lane, wave); }
    SEAM(0);
    if (IN(1)) for (int rep = 0; rep < REP_G1; ++rep) {
        pg8::Gemm g{(const bf16*)(ws + WS_XN), (const bf16*)(ws + WS_WIN), MP, NIN, D}; pg8::StaticOrder S; S.init(MP, NIN, gridDim.x, (int)blockIdx.x);
        EpiIn E{(bf16*)(ws + WS_QS), (float*)(ws + WS_LF), (bf16*)(ws + WS_V), (bf16*)(ws + WS_G), (bf16*)(ws + WS_U), (const float*)(ws + WS_CTL)};
        pg8::gemm_phase<EpiIn, pg8::StaticOrder, true, true>(lds, g, S, E);
    }
    SEAM(1);
    if (IN(2)) for (int rep = 0; rep < REP_P2; ++rep) { hgrn_local(args, lds, tid, lane, wave); conv_prompt(args, lds, tid, lane, wave); conv_sample(args, lds, tid, lane, wave); hgrn_sample(args, lds, tid, lane, wave); }
    SEAM(2);
    if (IN(3)) { hgrn_scan(args, tid); }
    SEAM(3);
    if (IN(4)) for (int rep = 0; rep < REP_P2; ++rep) { hgrn_out(args, lds, tid, lane, wave); }
    SEAM(4);
    if (IN(5)) {
        pg8::Gemm g{(const bf16*)(ws + WS_A2), (const bf16*)(ws + WS_WOUT), MP, D, D}; pg8::StaticOrder S; S.init(MP, D, gridDim.x, (int)blockIdx.x);
        EpiOut E{R, (bf16*)(ws + WS_XN), args.in[I_GFFN], (float*)(ws + WS_CTL) + 16384};
        pg8::gemm_phase<EpiOut, pg8::StaticOrder, true, true>(lds, g, S, E);
    }
    SEAM(5);
    if (IN(6)) {
        pg8::Gemm g{(const bf16*)(ws + WS_XN), (const bf16*)(ws + WS_WGU), MP, 2 * FF, D}; pg8::StaticOrder S; S.init(MP, 2 * FF, gridDim.x, (int)blockIdx.x);
        EpiGU E{(const float*)(ws + WS_CTL) + 16384, (bf16*)(ws + WS_A4)};
        pg8::gemm_phase<EpiGU, pg8::StaticOrder, true, true>(lds, g, S, E);
    }
    SEAM(6);
    if (IN(7)) {
        pg8::Gemm g{(const bf16*)(ws + WS_A4), (const bf16*)(ws + WS_WD), MP, D, FF}; pg8::StaticOrder S; S.init(MP, D, gridDim.x, (int)blockIdx.x);
        EpiDown E{R, (float*)(ws + WS_CTL) + 32768};
        pg8::gemm_phase<EpiDown, pg8::StaticOrder, true, true>(lds, g, S, E);
    }
    SEAM(7);
    if (IN(8)) { final_norm(args, lane, wave); }
#undef IN
#undef SEAM
}

#ifndef MK_N_LAUNCHES
#define MK_N_LAUNCHES 1
#endif
extern "C" void kernel_launch(void* const* d_in, const int* in_sizes, int n_in, void* d_out, int out_size, void* d_ws, size_t ws_size, hipStream_t stream) {
    static int grid = 0;
    if (grid == 0) {
        if (n_in != 19 || (size_t)out_size != O_END || ws_size < WS_END) { fprintf(stderr, "kernel_launch: unexpected shapes: n_in %d out %d ws %zu (need %zu)\n", n_in, out_size, ws_size, (size_t)WS_END); grid = -1; return; }
        int dev = 0, cus = 0, per_cu = 0;
        if (hipGetDevice(&dev) != hipSuccess || hipDeviceGetAttribute(&cus, hipDeviceAttributeMultiprocessorCount, dev) != hipSuccess) { grid = -1; return; }
        if (hipFuncSetAttribute((const void*)hymba_fwd, hipFuncAttributeMaxDynamicSharedMemorySize, LDS_BYTES) != hipSuccess) { fprintf(stderr, "kernel_launch: hipFuncSetAttribute failed\n"); grid = -1; return; }
        if (hipOccupancyMaxActiveBlocksPerMultiprocessor(&per_cu, (const void*)hymba_fwd, 512, LDS_BYTES) != hipSuccess || per_cu < 1) { fprintf(stderr, "kernel_launch: occupancy query failed (%d)\n", per_cu); (void)hipGetLastError(); grid = -1; return; }
        grid = cus * per_cu;
        fprintf(stderr, "kernel_launch: grid %d (%d CUs x %d)\n", grid, cus, per_cu);
    }
    if (grid < 0) return;
    if (hipMemsetAsync((char*)d_ws + WS_BAR, 0, BAR_BYTES, stream) != hipSuccess) { fprintf(stderr, "kernel_launch: memset failed\n"); return; }
    Args a{};
    for (int i = 0; i < 19; ++i) a.in[i] = (const float*)d_in[i];
    a.out = (float*)d_out; a.ws = (unsigned char*)d_ws;
#if MK_N_LAUNCHES == 1
    a.ph_lo = 0; a.ph_hi = NPHASE;
    void* kargs[] = {&a};
    hipError_t e = hipLaunchCooperativeKernel((const void*)hymba_fwd, dim3(grid), dim3(512), kargs, LDS_BYTES, stream);
    if (e != hipSuccess) fprintf(stderr, "kernel_launch: cooperative launch failed: %s (grid %d)\n", hipGetErrorString(e), grid);
#else
    for (int p = 0; p < NPHASE; ++p) { a.ph_lo = p; a.ph_hi = p + 1; hipLaunchKernelGGL(hymba_fwd, dim3(grid), dim3(512), LDS_BYTES, stream, a); }
#endif
}
```

```cpp
#include <hip/hip_runtime.h>
#include <hip/hip_cooperative_groups.h>
#include <cstdio>
#include <cstdint>
namespace cg = cooperative_groups;
namespace pg8 {
#define PG8_LAS __attribute__((address_space(3)))
typedef unsigned short bf16_t;
typedef short bf16x8 __attribute__((ext_vector_type(8)));
typedef float f32x4 __attribute__((ext_vector_type(4)));
typedef unsigned u32x4 __attribute__((ext_vector_type(4)));
constexpr int BM = 256, BK = 64, HALF = 128, HTB = HALF * BK * 2  , STAGE_BYTES = 8 * HTB, NXCD = 8, WGM = 8;

__host__ __device__ __forceinline__ int lds_byte(int r, int c) { const int st = (r >> 4) * 2 + (c >> 5), rr = r & 15, cc = c & 31, ob = rr * 64 + cc * 2; return st * 1024 + (ob ^ (((ob >> 9) & 1) << 5)); }
__host__ __device__ __forceinline__ void stage_rc(int b, int& R, int& C) { const int st = b / 1024, sb = b % 1024, swz = sb ^ (((sb >> 9) & 1) << 5); R = (st >> 1) * 16 + swz / 64; C = (st & 1) * 32 + (swz % 64) / 2; }
__host__ __device__ __forceinline__ int perm32(int rho) { const int n = rho >> 4, i = rho & 15; return 8 * (i >> 2) + 4 * n + (i & 3); }

struct Unit { int pm, pn, k0, nt; };
struct Gemm { const bf16_t* A; const bf16_t* Bt; int M, N, K; };

struct StaticOrder {
    int nM, nN, nwg, G, c, ntf;
    __host__ __device__ void init(int M, int N, int G_, int c_, int K_) { nM = M / BM; nN = N / BM; nwg = nM * nN; G = G_; c = c_; ntf = K_ / BK; }
    __host__ __device__ bool next(int i, Unit& u) const {
        const long L = (long)i * G + c; if (L >= nwg) return false;
        int wgid = (int)L; { const int q = nwg / NXCD, r = nwg % NXCD, xcd = wgid % NXCD, off = wgid / NXCD; wgid = (xcd < r ? xcd * (q + 1) : r * (q + 1) + (xcd - r) * q) + off; }
        const int nig = WGM * nN, gid = wgid / nig, fm = gid * WGM, gsz = (nM - fm) < WGM ? (nM - fm) : WGM;
        u.pm = fm + ((wgid % nig) % gsz); u.pn = (wgid % nig) / gsz; u.k0 = 0; u.nt = ntf; return true;
    }
    __device__ __forceinline__ void a_ready(const Unit&) const {}
    __device__ __forceinline__ void done(const Unit&) const {}
};
__device__ __forceinline__ unsigned cvt_pk_bf16(float lo, float hi) { unsigned r; asm volatile("v_cvt_pk_bf16_f32 %0, %1, %2" : "=v"(r) : "v"(lo), "v"(hi)); return r; }
template <class Epi, class Sched, bool ALIGN_EPI = false, bool SP2 = false>
__device__ __forceinline__ void gemm_phase(PG8_LAS unsigned char* lds, const Gemm g, const Sched& S, const Epi& E) {
    const int tid = threadIdx.x, wid = __builtin_amdgcn_readfirstlane(tid >> 6), lane = tid & 63, wr = wid >> 2, wc = wid & 3, fr = lane & 15, fq = lane >> 4;
    const int K = g.K;
    unsigned voffA[2], voffB[2];
#pragma unroll
    for (int i = 0; i < 2; ++i) { int R, C; stage_rc(tid * 16 + i * 8192, R, C); const int Rb = Epi::PERM ? ((R & ~31) + perm32(R & 31)) : R;
        voffA[i] = (unsigned)(R * K + C) * 2u; voffB[i] = (unsigned)(Rb * K + C) * 2u; }
    const size_t kstep = (size_t)(BK * 2);
    const size_t hstep = (size_t)HALF * K * 2;
    const size_t tstep = 2 * hstep;
    const unsigned ldsw = (unsigned)wid * 1024u;
    const int aoff = lds_byte(wr * 64 + fr, fq * 8), boff = lds_byte(wc * 32 + fr, fq * 8);
#define PG8_SA(b, h) (((b) * 2 + (h)) * HTB)
#define PG8_SB(b, h) ((4 + (b) * 2 + (h)) * HTB)
#define PG8_STAGE(bufoff, gbase, voff) do { _Pragma("unroll") for (int _i = 0; _i < 2; ++_i) \
        __builtin_amdgcn_global_load_lds((const unsigned*)((const char*)(gbase) + (voff)[_i]), (PG8_LAS unsigned*)(lds + (bufoff) + ldsw + _i * 8192), 16, 0, 0); } while (0)
#define PG8_LDA(dst, b, h) do { _Pragma("unroll") for (int m = 0; m < 4; ++m) _Pragma("unroll") for (int k = 0; k < 2; ++k) dst[m][k] = *(const PG8_LAS bf16x8*)(lds + PG8_SA(b, h) + aoff + m * 2048 + k * 1024); } while (0)
#define PG8_LDB(dst, b, h) do { _Pragma("unroll") for (int n = 0; n < 2; ++n) _Pragma("unroll") for (int k = 0; k < 2; ++k) dst[n][k] = *(const PG8_LAS bf16x8*)(lds + PG8_SB(b, h) + boff + n * 2048 + k * 1024); } while (0)
#define PG8_MMA(ai, bj, At, Bt) do { __builtin_amdgcn_s_setprio(1); _Pragma("unroll") for (int m = 0; m < 4; ++m) _Pragma("unroll") for (int n = 0; n < 2; ++n) _Pragma("unroll") for (int k = 0; k < 2; ++k) \
        acc[ai][bj][m][n] = __builtin_amdgcn_mfma_f32_16x16x32_bf16(Bt[n][k], At[m][k], acc[ai][bj][m][n], 0, 0, 0); __builtin_amdgcn_s_setprio(0); } while (0)
#define PG8_WAIT_V(n) asm volatile("s_waitcnt vmcnt(" #n ")" ::: "memory")
#define PG8_WAIT_L(n) asm volatile("s_waitcnt lgkmcnt(" #n ")" ::: "memory")
#define PG8_BAR __builtin_amdgcn_s_barrier()
#define PG8_SCHED __builtin_amdgcn_sched_barrier(0)
    Unit cur, nxt; int ui = 0;
    if (!S.next(0, cur)) return;
    f32x4 acc[2][2][4][2];
#pragma unroll
    for (int a = 0; a < 2; ++a)
#pragma unroll
        for (int b = 0; b < 2; ++b)
#pragma unroll
            for (int m = 0; m < 4; ++m)
#pragma unroll
                for (int n = 0; n < 2; ++n) acc[a][b][m][n] = (f32x4){0.f, 0.f, 0.f, 0.f};
    bf16x8 At[4][2], B0[2][2], B1[2][2];
    const char* cA = (const char*)g.A + (size_t)cur.pm * tstep + (size_t)cur.k0 * 2; const char* cB = (const char*)g.Bt + (size_t)cur.pn * tstep + (size_t)cur.k0 * 2;
    S.a_ready(cur);
    if constexpr (SP2) {
        PG8_STAGE(PG8_SB(0, 0), cB, voffB); PG8_STAGE(PG8_SB(0, 1), cB + hstep, voffB); PG8_STAGE(PG8_SA(0, 0), cA, voffA); PG8_STAGE(PG8_SA(0, 1), cA + hstep, voffA);
        if (wr == 1) PG8_BAR;
        PG8_WAIT_V(2); PG8_BAR;
        PG8_STAGE(PG8_SB(1, 0), cB + kstep, voffB); PG8_STAGE(PG8_SA(1, 0), cA + kstep, voffA); PG8_STAGE(PG8_SB(1, 1), cB + hstep + kstep, voffB);
        PG8_WAIT_V(6); PG8_BAR;
    } else {
        PG8_STAGE(PG8_SB(0, 0), cB, voffB); PG8_STAGE(PG8_SA(0, 0), cA, voffA); PG8_STAGE(PG8_SB(0, 1), cB + hstep, voffB); PG8_STAGE(PG8_SA(0, 1), cA + hstep, voffA);
        if (wr == 1) PG8_BAR;
        PG8_WAIT_V(4); PG8_BAR;
        PG8_STAGE(PG8_SB(1, 0), cB + kstep, voffB); PG8_STAGE(PG8_SA(1, 0), cA + kstep, voffA); PG8_STAGE(PG8_SB(1, 1), cB + hstep + kstep, voffB);
        PG8_WAIT_V(6); PG8_BAR;
    }
    for (;;) {
        const bool has_next = S.next(ui + 1, nxt);
        const char* nA = has_next ? (const char*)g.A + (size_t)nxt.pm * tstep + (size_t)nxt.k0 * 2 : cA; const char* nB = has_next ? (const char*)g.Bt + (size_t)nxt.pn * tstep + (size_t)nxt.k0 * 2 : cB;
        const int nt = cur.nt;
        for (int t = 0; t < nt; t += 2) {
            const bool last = (t == nt - 2);
            const char* a1 = cA + (size_t)(t + 1) * kstep;
            const char* a2 = last ? nA : cA + (size_t)(t + 2) * kstep; const char* b2 = last ? nB : cB + (size_t)(t + 2) * kstep;
            const char* a3 = a2 + kstep; const char* b3 = b2 + kstep;
            if (last && has_next) S.a_ready(nxt);
            if constexpr (SP2) {
            PG8_LDB(B0, 0, 0); PG8_LDB(B1, 0, 1); PG8_SCHED; PG8_LDA(At, 0, 0); PG8_STAGE(PG8_SA(1, 1), a1 + hstep, voffA);
            PG8_WAIT_V(8); PG8_WAIT_L(0); PG8_BAR; PG8_MMA(0, 0, At, B0); PG8_MMA(0, 1, At, B1); PG8_BAR; PG8_SCHED;
            PG8_LDA(At, 0, 1); PG8_STAGE(PG8_SB(0, 0), b2, voffB); PG8_STAGE(PG8_SB(0, 1), b2 + hstep, voffB); PG8_STAGE(PG8_SA(0, 0), a2, voffA);
            PG8_WAIT_V(8); PG8_WAIT_L(0); PG8_BAR; PG8_MMA(1, 0, At, B0); PG8_MMA(1, 1, At, B1); PG8_BAR; PG8_SCHED;
            PG8_LDB(B0, 1, 0); PG8_LDB(B1, 1, 1); PG8_SCHED; PG8_LDA(At, 1, 0); PG8_STAGE(PG8_SA(0, 1), a2 + hstep, voffA);
            PG8_WAIT_V(8); PG8_WAIT_L(0); PG8_BAR; PG8_MMA(0, 0, At, B0); PG8_MMA(0, 1, At, B1); PG8_BAR; PG8_SCHED;
            PG8_LDA(At, 1, 1); PG8_STAGE(PG8_SB(1, 0), b3, voffB); PG8_STAGE(PG8_SB(1, 1), b3 + hstep, voffB); PG8_STAGE(PG8_SA(1, 0), a3, voffA);
            PG8_WAIT_V(8); PG8_WAIT_L(0); PG8_BAR; PG8_MMA(1, 0, At, B0); PG8_MMA(1, 1, At, B1); PG8_BAR; PG8_SCHED;
            } else {
            PG8_LDB(B0, 0, 0); PG8_SCHED; PG8_LDA(At, 0, 0); PG8_STAGE(PG8_SA(1, 1), a1 + hstep, voffA);
            PG8_WAIT_L(8); PG8_BAR; PG8_WAIT_L(0); PG8_MMA(0, 0, At, B0); PG8_BAR; PG8_SCHED;
            PG8_LDB(B1, 0, 1); PG8_STAGE(PG8_SB(0, 0), b2, voffB);
            PG8_BAR; PG8_WAIT_L(0); PG8_MMA(0, 1, At, B1); PG8_BAR;
            PG8_LDA(At, 0, 1); PG8_STAGE(PG8_SA(0, 0), a2, voffA);
            PG8_BAR; PG8_WAIT_L(0); PG8_MMA(1, 0, At, B0); PG8_BAR; PG8_SCHED;
            PG8_STAGE(PG8_SB(0, 1), b2 + hstep, voffB);
            PG8_WAIT_V(6); PG8_BAR; PG8_MMA(1, 1, At, B1); PG8_BAR;
            PG8_LDB(B0, 1, 0); PG8_SCHED; PG8_LDA(At, 1, 0); PG8_STAGE(PG8_SA(0, 1), a2 + hstep, voffA);
            PG8_WAIT_L(8); PG8_BAR; PG8_WAIT_L(0); PG8_MMA(0, 0, At, B0); PG8_BAR; PG8_SCHED;
            PG8_LDB(B1, 1, 1); PG8_STAGE(PG8_SB(1, 0), b3, voffB);
            PG8_BAR; PG8_WAIT_L(0); PG8_MMA(0, 1, At, B1); PG8_BAR;
            PG8_LDA(At, 1, 1); PG8_STAGE(PG8_SA(1, 0), a3, voffA);
            PG8_BAR; PG8_WAIT_L(0); PG8_MMA(1, 0, At, B0); PG8_BAR; PG8_SCHED;
            PG8_STAGE(PG8_SB(1, 1), b3 + hstep, voffB);
            PG8_WAIT_V(6); PG8_BAR; PG8_MMA(1, 1, At, B1); PG8_BAR;
            }
        }
        if constexpr (ALIGN_EPI) { if (wr == 0) PG8_BAR; }
        if constexpr (!Epi::AFTER_DRAIN) { E(acc, cur, wr, wc, fr, fq); S.done(cur); }
        if (!has_next) break;
#pragma unroll
        for (int a = 0; a < 2; ++a)
#pragma unroll
            for (int b = 0; b < 2; ++b)
#pragma unroll
                for (int m = 0; m < 4; ++m)
#pragma unroll
                    for (int n = 0; n < 2; ++n) acc[a][b][m][n] = (f32x4){0.f, 0.f, 0.f, 0.f};
        cur = nxt; cA = nA; cB = nB; ++ui;
        if constexpr (ALIGN_EPI) { if (wr == 1) PG8_BAR; }
    }
    PG8_WAIT_V(0);
    if constexpr (!ALIGN_EPI) { if (wr == 0) PG8_BAR; }
    PG8_BAR;
    if constexpr (Epi::AFTER_DRAIN) { E.fused(acc, cur, wr, wc, fr, fq, lds, wid, lane); S.done(cur); }
#undef PG8_SA
#undef PG8_SB
#undef PG8_STAGE
#undef PG8_LDA
#undef PG8_LDB
#undef PG8_MMA
#undef PG8_WAIT_V
#undef PG8_WAIT_L
#undef PG8_BAR
#undef PG8_SCHED
}
}

constexpr int D = 2048, NB = 4, SEQ = 2048, NMETA = 16, TP = SEQ + NMETA, MPROMPT = NB * TP, NS = 128, MREAL = MPROMPT + NS, MP = 8448;
constexpr int AW = 1024, NH = 8, NCHUNK = 33, CW = 31, FF = 5632, NIN = 6144, NITEM = NB * NH * NCHUNK;
constexpr float EPS = 1e-6f;
static_assert(MP % 256 == 0 && MP >= MREAL, "row padding");

constexpr size_t MiB = 1u << 20;
constexpr size_t WS_CTL = 0;
constexpr size_t WS_WIN = 1 * MiB, WS_WOUT = 25 * MiB, WS_WGU = 33 * MiB, WS_WD = 77 * MiB;
constexpr size_t WS_XN = 99 * MiB;
constexpr size_t WS_A2 = 132 * MiB;
constexpr size_t WS_QS = 165 * MiB, WS_V = WS_QS + 16896 * 1024, WS_G = WS_V + 16896 * 1024, WS_U = WS_G + 16896 * 1024;
constexpr size_t WS_LF = 231 * MiB;
constexpr size_t WS_SB = 264 * MiB;
constexpr size_t WS_AC = 297 * MiB;
constexpr size_t WS_A4 = 165 * MiB;
constexpr size_t WS_END = 298 * MiB;
constexpr size_t WS_PART = WS_WIN;
static_assert(WS_A4 + (size_t)MP * FF * 2 <= WS_AC && WS_SB + (size_t)NITEM * 32768 <= WS_AC && WS_LF + (size_t)MP * 1024 * 4 <= WS_SB, "ws map");

constexpr int LDS_BYTES = 147456, LDS_MISC = 131072;
constexpr size_t WS_BAR = 256 * 1024, BAR_BYTES = 16384;
#define LAS __attribute__((address_space(3)))
typedef unsigned short bf16;
typedef unsigned v4u __attribute__((ext_vector_type(4)));
typedef unsigned v2u __attribute__((ext_vector_type(2)));
typedef float f32x4 __attribute__((ext_vector_type(4)));
typedef short bf16x8 __attribute__((ext_vector_type(8)));

__device__ __forceinline__ unsigned f2bf(float f) { unsigned u = __builtin_bit_cast(unsigned, f); return (u + 0x7fffu + ((u >> 16) & 1u)) >> 16; }
__device__ __forceinline__ unsigned pk2(float lo, float hi) { return f2bf(lo) | (f2bf(hi) << 16); }
__device__ __forceinline__ float bf2f(unsigned b) { return __builtin_bit_cast(float, b << 16); }
__device__ __forceinline__ float bflo(unsigned w) { return __builtin_bit_cast(float, w << 16); }
__device__ __forceinline__ float bfhi(unsigned w) { return __builtin_bit_cast(float, w & 0xffff0000u); }
__device__ __forceinline__ float sigmoidf_(float x) { return 1.f / (1.f + __expf(-x)); }
__device__ __forceinline__ float siluf_(float x) { return x / (1.f + __expf(-x)); }
__device__ __forceinline__ float wave_sum(float v) {
#pragma unroll
    for (int o = 1; o < 64; o <<= 1) v += __shfl_xor(v, o);
    return v;
}

struct Args { const float* in[19]; float* out; unsigned char* ws; int ph_lo, ph_hi; };
enum { I_XP = 0, I_XS, I_SH, I_SC, I_META, I_GMIX, I_WIN, I_LB, I_HG, I_CWT, I_CB, I_GNG, I_GNB, I_WOUT, I_GFFN, I_WG, I_WU, I_WD, I_GFIN };
constexpr size_t O_YP = 0, O_YS = (size_t)NB * SEQ * D, O_SHP = O_YS + (size_t)NS * D, O_SCP = O_SHP + (size_t)NB * NH * 128 * 128,
                 O_SHS = O_SCP + (size_t)NB * 30 * 1024, O_SCS = O_SHS + (size_t)NS * NH * 128 * 128, O_END = O_SCS + (size_t)NS * 30 * 1024;

struct RowMap { const float* xp; const float* xs; const float* meta; float* out; };
__device__ __forceinline__ const float* src_row(const RowMap& R, int r) {
    if (r >= MPROMPT) return R.xs + (size_t)(r - MPROMPT) * D;
    const int b = r / TP, t = r - b * TP;
    return t < NMETA ? R.meta + (size_t)t * D : R.xp + ((size_t)b * SEQ + (t - NMETA)) * D;
}
__device__ __forceinline__ float* out_row(const RowMap& R, int r) {
    if (r >= MPROMPT) return R.out + O_YS + (size_t)(r - MPROMPT) * D;
    const int b = r / TP, t = r - b * TP;
    return t < NMETA ? nullptr : R.out + O_YP + ((size_t)b * SEQ + (t - NMETA)) * D;
}

using pg8::Unit;
struct EpiIn {
    static constexpr bool PERM = true, AFTER_DRAIN = false;
    bf16* Qs; float* LF; bf16* V; bf16* G; bf16* U; const float* lbv;
    __device__ __forceinline__ void operator()(const f32x4 (&acc)[2][2][4][2], const Unit& u, int wr, int wc, int fr, int fq) const {
        const int row0 = u.pm * 256 + wr * 64 + fr;
        if (u.pn >= 16) {
            const int c0 = (u.pn - 16) * 128 + wc * 32 + 8 * fq;
#pragma unroll
            for (int ai = 0; ai < 2; ++ai)
#pragma unroll
                for (int m = 0; m < 4; ++m) {
                    const size_t row = (size_t)(row0 + ai * 128 + m * 16);
                    float o[8];
#pragma unroll
                    for (int n = 0; n < 2; ++n)
#pragma unroll
                        for (int j = 0; j < 4; ++j) o[n * 4 + j] = acc[ai][0][m][n][j] * sigmoidf_(acc[ai][1][m][n][j]);
                    v4u w; w.x = pg8::cvt_pk_bf16(o[0], o[1]); w.y = pg8::cvt_pk_bf16(o[2], o[3]); w.z = pg8::cvt_pk_bf16(o[4], o[5]); w.w = pg8::cvt_pk_bf16(o[6], o[7]);
                    *(v4u*)(U + row * 1024 + c0) = w;
                }
            return;
        }
        const int kind = u.pn >> 2, cb = (u.pn & 3) * 256 + wc * 32 + 8 * fq;
        if (kind == 1) {
            f32x4 lb[2][2];
#pragma unroll
            for (int bj = 0; bj < 2; ++bj)
#pragma unroll
                for (int n = 0; n < 2; ++n) lb[bj][n] = *(const f32x4*)(lbv + cb + bj * 128 + 4 * n);
#pragma unroll
            for (int ai = 0; ai < 2; ++ai)
#pragma unroll
                for (int m = 0; m < 4; ++m) {
                    const size_t row = (size_t)(row0 + ai * 128 + m * 16);
#pragma unroll
                    for (int bj = 0; bj < 2; ++bj)
#pragma unroll
                        for (int n = 0; n < 2; ++n) {
                            f32x4 o;
#pragma unroll
                            for (int j = 0; j < 4; ++j) { const float l = lb[bj][n][j]; o[j] = __logf(l + (1.f - l) * sigmoidf_(acc[ai][bj][m][n][j])); }
                            *(f32x4*)(LF + row * 1024 + cb + bj * 128 + 4 * n) = o;
                        }
                }
            return;
        }
        bf16* dst = Qs + (size_t)(kind == 0 ? 0 : kind - 1) * ((size_t)MP * 1024);
#pragma unroll
        for (int ai = 0; ai < 2; ++ai)
#pragma unroll
            for (int m = 0; m < 4; ++m) {
                const size_t row = (size_t)(row0 + ai * 128 + m * 16);
#pragma unroll
                for (int bj = 0; bj < 2; ++bj) {
                    float o[8];
#pragma unroll
                    for (int n = 0; n < 2; ++n)
#pragma unroll
                        for (int j = 0; j < 4; ++j) { const float x = acc[ai][bj][m][n][j]; o[n * 4 + j] = (kind == 2) ? x : siluf_(x); }
                    v4u w; w.x = pg8::cvt_pk_bf16(o[0], o[1]); w.y = pg8::cvt_pk_bf16(o[2], o[3]); w.z = pg8::cvt_pk_bf16(o[4], o[5]); w.w = pg8::cvt_pk_bf16(o[6], o[7]);
                    *(v4u*)(dst + row * 1024 + cb + bj * 128) = w;
                }
            }
    }
};

struct EpiOut {
    static constexpr bool PERM = true, AFTER_DRAIN = false;
    RowMap R; bf16* A3; const float* gffn; float* rowss;
    __device__ __forceinline__ void operator()(const f32x4 (&acc)[2][2][4][2], const Unit& u, int wr, int wc, int fr, int fq) const {
        const int row0 = u.pm * 256 + wr * 64 + fr, c0 = u.pn * 256 + wc * 32 + 8 * fq;
        f32x4 gv[2][2];
#pragma unroll
        for (int bj = 0; bj < 2; ++bj)
#pragma unroll
            for (int n = 0; n < 2; ++n) gv[bj][n] = *(const f32x4*)(gffn + c0 + bj * 128 + 4 * n);
#pragma unroll
        for (int ai = 0; ai < 2; ++ai)
#pragma unroll
            for (int m = 0; m < 4; ++m) {
                const int row = row0 + ai * 128 + m * 16;
                float ss = 0.f;
                if (row < MREAL) {
                    const float* src = src_row(R, row) + c0; float* dst = out_row(R, row);
#pragma unroll
                    for (int bj = 0; bj < 2; ++bj) {
                        f32x4 h[2];
#pragma unroll
                        for (int n = 0; n < 2; ++n) { h[n] = acc[ai][bj][m][n] + *(const f32x4*)(src + bj * 128 + 4 * n);
                            ss += (h[n][0] * h[n][0] + h[n][1] * h[n][1]) + (h[n][2] * h[n][2] + h[n][3] * h[n][3]);
                            if (dst) *(f32x4*)(dst + c0 + bj * 128 + 4 * n) = h[n]; }
                        const f32x4 a = h[0] * gv[bj][0], b = h[1] * gv[bj][1];
                        v4u w; w.x = pg8::cvt_pk_bf16(a[0], a[1]); w.y = pg8::cvt_pk_bf16(a[2], a[3]); w.z = pg8::cvt_pk_bf16(b[0], b[1]); w.w = pg8::cvt_pk_bf16(b[2], b[3]);
                        *(v4u*)(A3 + (size_t)row * D + c0 + bj * 128) = w;
                    }
                }
                ss += __shfl_xor(ss, 16); ss += __shfl_xor(ss, 32);
                if (fq == 0 && row < MREAL) atomicAdd(rowss + row, ss);
            }
    }
};

struct EpiGU {
    static constexpr bool PERM = true, AFTER_DRAIN = false;
    const float* rowss; bf16* A4;
    __device__ __forceinline__ void operator()(const f32x4 (&acc)[2][2][4][2], const Unit& u, int wr, int wc, int fr, int fq) const {
        const int row0 = u.pm * 256 + wr * 64 + fr, c0 = u.pn * 128 + wc * 32 + 8 * fq;
#pragma unroll
        for (int ai = 0; ai < 2; ++ai)
#pragma unroll
            for (int m = 0; m < 4; ++m) {
                const int row = row0 + ai * 128 + m * 16;
                const float rstd = rsqrtf(rowss[row] * (1.f / D) + EPS);
                float o[8];
#pragma unroll
                for (int n = 0; n < 2; ++n)
#pragma unroll
                    for (int j = 0; j < 4; ++j) o[n * 4 + j] = siluf_(acc[ai][0][m][n][j] * rstd) * (acc[ai][1][m][n][j] * rstd);
                v4u w; w.x = pg8::cvt_pk_bf16(o[0], o[1]); w.y = pg8::cvt_pk_bf16(o[2], o[3]); w.z = pg8::cvt_pk_bf16(o[4], o[5]); w.w = pg8::cvt_pk_bf16(o[6], o[7]);
                *(v4u*)(A4 + (size_t)row * FF + c0) = w;
            }
    }
};

constexpr int MAIN_ROWS = 8192, NSLICE = 11, SLICE_NT = 8;
static_assert(NSLICE * SLICE_NT * 64 == FF && MAIN_ROWS + 256 == MP, "down-proj split");
struct SplitOrder : pg8::StaticOrder {
    __host__ __device__ bool next(int i, Unit& u) const {
        const long L = (long)i * G + c;
        if (L < nwg) return pg8::StaticOrder::next(i, u);
        const int j = (int)(L - nwg); if (j >= NSLICE * (D / 256)) return false;
        u.pm = MAIN_ROWS / 256; u.pn = j & 7; u.k0 = (j >> 3) * (SLICE_NT * 64); u.nt = SLICE_NT; return true;
    }
};
struct EpiDown {
    static constexpr bool PERM = true, AFTER_DRAIN = false;
    RowMap R; float* part;
    __device__ __forceinline__ void operator()(const f32x4 (&acc)[2][2][4][2], const Unit& u, int wr, int wc, int fr, int fq) const {
        const int c0 = u.pn * 256 + wc * 32 + 8 * fq;
        if (u.nt == SLICE_NT) {
            float* pb = part + ((size_t)(u.k0 / (SLICE_NT * 64)) * 256 + wr * 64 + fr) * D + c0;
#pragma unroll
            for (int ai = 0; ai < 2; ++ai)
#pragma unroll
                for (int m = 0; m < 4; ++m)
#pragma unroll
                    for (int bj = 0; bj < 2; ++bj)
#pragma unroll
                        for (int n = 0; n < 2; ++n) *(f32x4*)(pb + (size_t)(ai * 128 + m * 16) * D + bj * 128 + 4 * n) = acc[ai][bj][m][n];
            return;
        }
        const int row0 = u.pm * 256 + wr * 64 + fr;
#pragma unroll
        for (int ai = 0; ai < 2; ++ai)
#pragma unroll
            for (int m = 0; m < 4; ++m) {
                const int row = row0 + ai * 128 + m * 16;
                float* dst = row < MREAL ? out_row(R, row) : nullptr;
                if (dst) {
#pragma unroll
                    for (int bj = 0; bj < 2; ++bj)
#pragma unroll
                        for (int n = 0; n < 2; ++n) { f32x4* p = (f32x4*)(dst + c0 + bj * 128 + 4 * n); *p = *p + acc[ai][bj][m][n]; }
                }
            }
    }
};

__device__ __forceinline__ void p0_transpose_item(const float* W, int K, int N, bf16* WT, int k0, int n0, int drow0, LAS float* scr, int lane) {
#pragma unroll 8
    for (int i = 0; i < 32; ++i) { const int kk = 2 * i + (lane >> 5); scr[kk * 33 + (lane & 31)] = W[(size_t)(k0 + kk) * N + n0 + (lane & 31)]; }
    asm volatile("s_waitcnt lgkmcnt(0)" ::: "memory");
    const int c = lane & 7;
#pragma unroll
    for (int j = 0; j < 4; ++j) { const int n = (lane >> 3) + 8 * j; const LAS float* s = scr + (8 * c) * 33 + n;
        v4u o; o.x = pk2(s[0 * 33], s[1 * 33]); o.y = pk2(s[2 * 33], s[3 * 33]); o.z = pk2(s[4 * 33], s[5 * 33]); o.w = pk2(s[6 * 33], s[7 * 33]);
        *(v4u*)(WT + (size_t)(drow0 + n) * K + k0 + 8 * c) = o; }
    asm volatile("s_waitcnt lgkmcnt(0)" ::: "memory");
}
__device__ __forceinline__ int glu_row(int n0) {
    if (n0 < 4096) return n0;
    if (n0 < 5120) { const int c = n0 - 4096; return 4096 + (c >> 7) * 256 + (c & 127); }
    const int c = n0 - 5120; return 4096 + (c >> 7) * 256 + 128 + (c & 127);
}
__device__ __forceinline__ void p0_prologue(const Args& a, LAS unsigned char* lds, int tid, int lane, int wave) {
    unsigned char* ws = a.ws;
    LAS float* scr = (LAS float*)(lds + wave * 16384);
    const int gw = blockIdx.x * 8 + wave, NGW = gridDim.x * 8;
    constexpr int I_IN = (D / 64) * (NIN / 32), I_OUT = (D / 64) * (D / 32), I_G = (D / 64) * (FF / 32), I_DN = (FF / 64) * (D / 32);
    constexpr int NITEMS = I_IN + I_OUT + 2 * I_G + I_DN;
    for (int it = gw; it < NITEMS; it += NGW) {
        int r = it;
        if (r < I_IN) { const int nblk = NIN / 32, kb = r / nblk, nb = r % nblk; p0_transpose_item(a.in[I_WIN], D, NIN, (bf16*)(ws + WS_WIN), 64 * kb, 32 * nb, glu_row(32 * nb), scr, lane); continue; } r -= I_IN;
        if (r < I_OUT) { const int nblk = D / 32, kb = r / nblk, nb = r % nblk; p0_transpose_item(a.in[I_WOUT], D, D, (bf16*)(ws + WS_WOUT), 64 * kb, 32 * nb, 32 * nb, scr, lane); continue; } r -= I_OUT;
        if (r < I_G) { const int nblk = FF / 32, kb = r / nblk, nb = r % nblk, n0 = 32 * nb; p0_transpose_item(a.in[I_WG], D, FF, (bf16*)(ws + WS_WGU), 64 * kb, n0, (n0 >> 7) * 256 + (n0 & 127), scr, lane); continue; } r -= I_G;
        if (r < I_G) { const int nblk = FF / 32, kb = r / nblk, nb = r % nblk, n0 = 32 * nb; p0_transpose_item(a.in[I_WU], D, FF, (bf16*)(ws + WS_WGU), 64 * kb, n0, (n0 >> 7) * 256 + 128 + (n0 & 127), scr, lane); continue; } r -= I_G;
        { const int nblk = D / 32, kb = r / nblk, nb = r % nblk; p0_transpose_item(a.in[I_WD], FF, D, (bf16*)(ws + WS_WD), 64 * kb, 32 * nb, 32 * nb, scr, lane); }
    }
    RowMap R{a.in[I_XP], a.in[I_XS], a.in[I_META], a.out};
    const float* gm = a.in[I_GMIX]; bf16* XN = (bf16*)(ws + WS_XN);
    for (int m = gw; m < MP; m += NGW) {
        v4u* o = (v4u*)(XN + (size_t)m * D) + lane;
        if (m >= MREAL) {
#pragma unroll
            for (int j = 0; j < 4; ++j) o[64 * j] = (v4u){0u, 0u, 0u, 0u};
            continue; }
        const f32x4* xr = (const f32x4*)src_row(R, m);
        f32x4 v[8]; float s = 0.f;
#pragma unroll
        for (int j = 0; j < 4; ++j) { v[2 * j] = xr[2 * lane + 128 * j]; v[2 * j + 1] = xr[2 * lane + 128 * j + 1]; }
#pragma unroll
        for (int j = 0; j < 8; ++j) s += (v[j][0] * v[j][0] + v[j][1] * v[j][1]) + (v[j][2] * v[j][2] + v[j][3] * v[j][3]);
        const float rstd = rsqrtf(wave_sum(s) * (1.f / D) + EPS);
#pragma unroll
        for (int j = 0; j < 4; ++j) { const f32x4 g0 = ((const f32x4*)gm)[2 * lane + 128 * j], g1 = ((const f32x4*)gm)[2 * lane + 128 * j + 1];
            const f32x4 a0 = v[2 * j] * rstd * g0, a1 = v[2 * j + 1] * rstd * g1;
            v4u w; w.x = pk2(a0[0], a0[1]); w.y = pk2(a0[2], a0[3]); w.z = pk2(a1[0], a1[1]); w.w = pk2(a1[2], a1[3]);
            o[64 * j] = w; }
    }
    float* ctl = (float*)(ws + WS_CTL);
    for (int i = blockIdx.x * 512 + tid; i < AW; i += gridDim.x * 512) { const float l0 = a.in[I_LB][i], l1 = a.in[I_LB][AW + i]; const float mx = fmaxf(l0, l1);
        const float e0 = __expf(l0 - mx), e1 = __expf(l1 - mx); ctl[i] = e0 / (e0 + e1); }
    for (int i = blockIdx.x * 512 + tid; i < MP; i += gridDim.x * 512) { ctl[16384 + i] = 0.f; ctl[32768 + i] = 0.f; }
}

constexpr int L_KT2 = 2048, L_TOT = 0, L_QP = 2048, L_QT = 19456, L_KT = 36864, L_VT = 54272, L_ST = 72704, L_PM = 107520, L_OB = 19456;
constexpr int RS_K = 136, RS_S = 72;
__device__ __forceinline__ void chunk_rows(int it, int& rowbase, int& nvalid, int& col0) {
    const int c = it % NCHUNK, bh = it / NCHUNK, h = bh & 7, b = bh >> 3;
    col0 = h * 128;
    if (c == 0) { rowbase = b * TP; nvalid = NMETA; } else { rowbase = b * TP + NMETA + (c - 1) * 64; nvalid = 64; }
}
__device__ __forceinline__ bf16x8 lds_frag(const LAS unsigned char* p) { return *(const LAS bf16x8*)p; }

__device__ __forceinline__ void hgrn_local(const Args& a, LAS unsigned char* lds, int tid, int lane, int wave) {
    unsigned char* ws = a.ws;
    const float* LF = (const float*)(ws + WS_LF); const bf16* V = (const bf16*)(ws + WS_V);
    bf16* SB = (bf16*)(ws + WS_SB); float* AC = (float*)(ws + WS_AC);
    LAS float* tot = (LAS float*)(lds + L_TOT);
    const int c_ = tid & 127, seg = tid >> 7;
    for (int it = blockIdx.x; it < NITEM; it += gridDim.x) {
        int rowbase, nvalid, col0; chunk_rows(it, rowbase, nvalid, col0);
        float lf[16], pre[16];
#pragma unroll
        for (int i = 0; i < 16; ++i) { const int s = seg * 16 + i; lf[i] = s < nvalid ? LF[(size_t)(rowbase + s) * 1024 + col0 + c_] : 0.f; }
        float run = 0.f;
#pragma unroll
        for (int i = 0; i < 16; ++i) { run += lf[i]; pre[i] = run; }
        tot[seg * 128 + c_] = run;
        unsigned vv[8];
#pragma unroll
        for (int i = 0; i < 8; ++i) { const int s = seg * 16 + 2 * i;
            const unsigned lo = s < nvalid ? V[(size_t)(rowbase + s) * 1024 + col0 + c_] : 0u, hi = s + 1 < nvalid ? V[(size_t)(rowbase + s + 1) * 1024 + col0 + c_] : 0u;
            vv[i] = lo | (hi << 16); }
        __syncthreads();
        const float t0 = tot[c_], t1 = tot[128 + c_], t2 = tot[256 + c_], t3 = tot[384 + c_];
        const float off = seg == 0 ? 0.f : (seg == 1 ? t0 : (seg == 2 ? t0 + t1 : t0 + t1 + t2)), blast = (t0 + t1) + (t2 + t3);
        unsigned kk[8];
#pragma unroll
        for (int i = 0; i < 8; ++i) {
            const float k0 = (1.f - __expf(lf[2 * i])) * __expf(blast - (off + pre[2 * i])), k1 = (1.f - __expf(lf[2 * i + 1])) * __expf(blast - (off + pre[2 * i + 1]));
            kk[i] = pk2(k0, k1); }
        LAS unsigned char* kt = lds + L_KT2 + c_ * (RS_S * 2) + seg * 32;
        LAS unsigned char* vt = lds + L_VT + c_ * (RS_S * 2) + seg * 32;
        *(LAS v4u*)kt = (v4u){kk[0], kk[1], kk[2], kk[3]}; *(LAS v4u*)(kt + 16) = (v4u){kk[4], kk[5], kk[6], kk[7]};
        *(LAS v4u*)vt = (v4u){vv[0], vv[1], vv[2], vv[3]}; *(LAS v4u*)(vt + 16) = (v4u){vv[4], vv[5], vv[6], vv[7]};
        if (seg == 0) AC[(size_t)it * 128 + c_] = __expf(blast);
        __syncthreads();
        const int r = lane & 15, q = lane >> 4;
        f32x4 acc[8];
#pragma unroll
        for (int n = 0; n < 8; ++n) acc[n] = (f32x4){0.f, 0.f, 0.f, 0.f};
#pragma unroll
        for (int ks = 0; ks < 2; ++ks) {
            const bf16x8 af = lds_frag(lds + L_KT2 + (wave * 16 + r) * (RS_S * 2) + (ks * 32 + q * 8) * 2);
#pragma unroll
            for (int n = 0; n < 8; ++n) { const bf16x8 bfm = lds_frag(lds + L_VT + (n * 16 + r) * (RS_S * 2) + (ks * 32 + q * 8) * 2);
                acc[n] = __builtin_amdgcn_mfma_f32_16x16x32_bf16(af, bfm, acc[n], 0, 0, 0); }
        }
        bf16* bt = SB + (size_t)it * 16384;
#pragma unroll
        for (int n = 0; n < 8; ++n) { v2u w; w.x = pk2(acc[n][0], acc[n][1]); w.y = pk2(acc[n][2], acc[n][3]);
            *(v2u*)(bt + (n * 16 + r) * 128 + wave * 16 + 4 * q) = w; }
        __syncthreads();
    }
}

__device__ __forceinline__ void hgrn_scan(const Args& a, int tid) {
    unsigned char* ws = a.ws; bf16* SB = (bf16*)(ws + WS_SB); const float* AC = (const float*)(ws + WS_AC);
    float* outS = a.out + O_SHP;
    for (int g = blockIdx.x * 512 + tid; g < NB * NH * 128 * 32; g += gridDim.x * 512) {
        const int bh = g >> 12, rem = g & 4095, v = rem >> 5, k4 = rem & 31;
        float S0 = 0.f, S1 = 0.f, S2 = 0.f, S3 = 0.f;
#pragma unroll 3
        for (int c = 0; c < NCHUNK; ++c) {
            const size_t it = (size_t)bh * NCHUNK + c;
            const f32x4 dec = *(const f32x4*)(AC + it * 128 + 4 * k4);
            v2u* p = (v2u*)(SB + it * 16384 + v * 128 + 4 * k4);
            const v2u bw = *p;
            v2u sw; sw.x = pk2(S0, S1); sw.y = pk2(S2, S3); *p = sw;
            S0 = dec[0] * S0 + bflo(bw.x); S1 = dec[1] * S1 + bfhi(bw.x); S2 = dec[2] * S2 + bflo(bw.y); S3 = dec[3] * S3 + bfhi(bw.y);
        }
        float* o = outS + ((size_t)bh * 128 + 4 * k4) * 128 + v;
        o[0] = S0; o[128] = S1; o[256] = S2; o[384] = S3;
    }
}

__device__ __forceinline__ void hgrn_out(const Args& a, LAS unsigned char* lds, int tid, int lane, int wave) {
    unsigned char* ws = a.ws;
    const float* LF = (const float*)(ws + WS_LF); const bf16* V = (const bf16*)(ws + WS_V); const bf16* Qs = (const bf16*)(ws + WS_QS); const bf16* G = (const bf16*)(ws + WS_G);
    const bf16* SB = (const bf16*)(ws + WS_SB); bf16* A2 = (bf16*)(ws + WS_A2); const float* hg = a.in[I_HG];
    LAS float* tot = (LAS float*)(lds + L_TOT);
    const int c_ = tid & 127, seg = tid >> 7;
    for (int it = blockIdx.x; it < NITEM; it += gridDim.x) {
        int rowbase, nvalid, col0; chunk_rows(it, rowbase, nvalid, col0);
        float lf[16], pre[16];
#pragma unroll
        for (int i = 0; i < 16; ++i) { const int s = seg * 16 + i; lf[i] = s < nvalid ? LF[(size_t)(rowbase + s) * 1024 + col0 + c_] : 0.f; }
        float run = 0.f;
#pragma unroll
        for (int i = 0; i < 16; ++i) { run += lf[i]; pre[i] = run; }
        tot[seg * 128 + c_] = run;
        unsigned vv[8];
#pragma unroll
        for (int i = 0; i < 8; ++i) { const int s = seg * 16 + 2 * i;
            const unsigned lo = s < nvalid ? V[(size_t)(rowbase + s) * 1024 + col0 + c_] : 0u, hi = s + 1 < nvalid ? V[(size_t)(rowbase + s + 1) * 1024 + col0 + c_] : 0u;
            vv[i] = lo | (hi << 16); }
        { LAS unsigned char* vt = lds + L_VT + c_ * (RS_S * 2) + seg * 32;
          *(LAS v4u*)vt = (v4u){vv[0], vv[1], vv[2], vv[3]}; *(LAS v4u*)(vt + 16) = (v4u){vv[4], vv[5], vv[6], vv[7]}; }
        { const v4u* sp = (const v4u*)(SB + (size_t)it * 16384);
#pragma unroll
          for (int j = 0; j < 4; ++j) { const int id = tid + 512 * j, v = id >> 4, kc = id & 15; *(LAS v4u*)(lds + L_ST + v * (RS_K * 2) + kc * 16) = sp[id]; } }
        float qv[16];
#pragma unroll
        for (int i = 0; i < 16; ++i) { const int s = seg * 16 + i; qv[i] = s < nvalid ? bf2f(Qs[(size_t)(rowbase + s) * 1024 + col0 + c_]) : 0.f; }
        __syncthreads();
        const float t0 = tot[c_], t1 = tot[128 + c_], t2 = tot[256 + c_];
        const float off = seg == 0 ? 0.f : (seg == 1 ? t0 : (seg == 2 ? t0 + t1 : t0 + t1 + t2)), bref = t0 + t1;
#pragma unroll
        for (int i = 0; i < 16; ++i) {
            const int s = seg * 16 + i; const float b = off + pre[i];
            const float qp = qv[i] * __expf(b), qt = qv[i] * __expf(fminf(b - bref, 80.f)), kt = (1.f - __expf(lf[i])) * __expf(fminf(bref - b, 80.f));
            ((LAS bf16*)(lds + L_QP))[s * RS_K + c_] = (bf16)f2bf(qp);
            ((LAS bf16*)(lds + L_QT))[s * RS_K + c_] = (bf16)f2bf(qt);
            ((LAS bf16*)(lds + L_KT))[s * RS_K + c_] = (bf16)f2bf(kt);
        }
        __syncthreads();
        const int r = lane & 15, q = lane >> 4;
        {
            const int sb = wave & 3, tb0 = (wave >> 2) * 2;
            f32x4 sc[2] = {(f32x4){0.f, 0.f, 0.f, 0.f}, (f32x4){0.f, 0.f, 0.f, 0.f}};
#pragma unroll
            for (int ks = 0; ks < 4; ++ks) {
                const bf16x8 af = lds_frag(lds + L_KT + (sb * 16 + r) * (RS_K * 2) + (ks * 32 + q * 8) * 2);
#pragma unroll
                for (int n = 0; n < 2; ++n) { const bf16x8 bfm = lds_frag(lds + L_QT + ((tb0 + n) * 16 + r) * (RS_K * 2) + (ks * 32 + q * 8) * 2);
                    sc[n] = __builtin_amdgcn_mfma_f32_16x16x32_bf16(af, bfm, sc[n], 0, 0, 0); }
            }
#pragma unroll
            for (int n = 0; n < 2; ++n) { const int t = (tb0 + n) * 16 + r, s0 = sb * 16 + 4 * q;
                const float p0 = s0 <= t ? sc[n][0] : 0.f, p1 = s0 + 1 <= t ? sc[n][1] : 0.f, p2 = s0 + 2 <= t ? sc[n][2] : 0.f, p3 = s0 + 3 <= t ? sc[n][3] : 0.f;
                v2u w; w.x = pk2(p0, p1); w.y = pk2(p2, p3);
                *(LAS v2u*)(lds + L_PM + t * (RS_S * 2) + s0 * 2) = w; }
        }
        __syncthreads();
        {
            const int tb = wave & 3, nv0 = (wave >> 2) * 4;
            f32x4 oc[4];
#pragma unroll
            for (int n = 0; n < 4; ++n) oc[n] = (f32x4){0.f, 0.f, 0.f, 0.f};
#pragma unroll
            for (int ks = 0; ks < 2; ++ks) {
                const bf16x8 af = lds_frag(lds + L_PM + (tb * 16 + r) * (RS_S * 2) + (ks * 32 + q * 8) * 2);
#pragma unroll
                for (int n = 0; n < 4; ++n) { const bf16x8 bfm = lds_frag(lds + L_VT + ((nv0 + n) * 16 + r) * (RS_S * 2) + (ks * 32 + q * 8) * 2);
                    oc[n] = __builtin_amdgcn_mfma_f32_16x16x32_bf16(af, bfm, oc[n], 0, 0, 0); }
            }
#pragma unroll
            for (int ks = 0; ks < 4; ++ks) {
                const bf16x8 af = lds_frag(lds + L_QP + (tb * 16 + r) * (RS_K * 2) + (ks * 32 + q * 8) * 2);
#pragma unroll
                for (int n = 0; n < 4; ++n) { const bf16x8 bfm = lds_frag(lds + L_ST + ((nv0 + n) * 16 + r) * (RS_K * 2) + (ks * 32 + q * 8) * 2);
                    oc[n] = __builtin_amdgcn_mfma_f32_16x16x32_bf16(af, bfm, oc[n], 0, 0, 0); }
            }
#pragma unroll
            for (int n = 0; n < 4; ++n)
#pragma unroll
                for (int j = 0; j < 4; ++j) ((LAS float*)(lds + L_OB))[(tb * 16 + 4 * q + j) * 132 + (nv0 + n) * 16 + r] = oc[n][j];
        }
        __syncthreads();
        {
            const int t = tid >> 3, part = tid & 7, v0 = part * 16;
            const LAS f32x4* op = (const LAS f32x4*)(lds + L_OB + (t * 132 + v0) * 4);
            f32x4 o4[4]; float ss = 0.f;
#pragma unroll
            for (int j = 0; j < 4; ++j) { o4[j] = op[j]; ss += (o4[j][0] * o4[j][0] + o4[j][1] * o4[j][1]) + (o4[j][2] * o4[j][2] + o4[j][3] * o4[j][3]); }
            ss += __shfl_xor(ss, 1); ss += __shfl_xor(ss, 2); ss += __shfl_xor(ss, 4);
            const float rstd = rsqrtf(ss * (1.f / 128.f) + EPS);
            if (t < nvalid) {
                const size_t row = (size_t)(rowbase + t);
                const v4u* gp = (const v4u*)(G + row * 1024 + col0 + v0); const f32x4* hp = (const f32x4*)(hg + col0 + v0);
                v4u* dst = (v4u*)(A2 + row * D + col0 + v0);
#pragma unroll
                for (int hhalf = 0; hhalf < 2; ++hhalf) { const v4u gw = gp[hhalf]; const f32x4 h0 = hp[2 * hhalf], h1 = hp[2 * hhalf + 1]; const f32x4 x0 = o4[2 * hhalf] * rstd * h0, x1 = o4[2 * hhalf + 1] * rstd * h1;
                    v4u w; w.x = pk2(x0[0] * bflo(gw.x), x0[1] * bfhi(gw.x)); w.y = pk2(x0[2] * bflo(gw.y), x0[3] * bfhi(gw.y));
                    w.z = pk2(x1[0] * bflo(gw.z), x1[1] * bfhi(gw.z)); w.w = pk2(x1[2] * bflo(gw.w), x1[3] * bfhi(gw.w));
                    dst[hhalf] = w; }
            }
        }
        __syncthreads();
    }
}

__device__ __forceinline__ void conv_prompt(const Args& a, LAS unsigned char* lds, int tid, int lane, int wave) {
    unsigned char* ws = a.ws; const bf16* U = (const bf16*)(ws + WS_U); bf16* A2 = (bf16*)(ws + WS_A2);
    const float* cw = a.in[I_CWT]; const float* cb = a.in[I_CB]; const float* gng = a.in[I_GNG]; const float* gnb = a.in[I_GNB];
    LAS float* red = (LAS float*)lds;
    constexpr int NTT = (TP + 31) / 32;
    for (int it = blockIdx.x; it < NB * NTT * 4; it += gridDim.x) {
        const int cbk = it & 3, tt = (it >> 2) % NTT, b = (it >> 2) / NTT;
        const int ch = cbk * 256 + (tid & 255), t0 = tt * 32 + (tid >> 8) * 16;
        float w[CW];
#pragma unroll
        for (int j = 0; j < CW; ++j) w[j] = cw[j * 1024 + ch];
        float uw[46];
#pragma unroll
        for (int j = 0; j < 46; ++j) { const int tok = t0 - 30 + j; uw[j] = (tok >= 0 && tok < TP) ? bf2f(U[(size_t)(b * TP + tok) * 1024 + ch]) : 0.f; }
        const float bias = cb[ch];
        float c[16];
#pragma unroll
        for (int i = 0; i < 16; ++i) { float s = bias;
#pragma unroll
            for (int j = 0; j < CW; ++j) s += w[j] * uw[i + j];
            c[i] = s; }
#pragma unroll
        for (int i = 0; i < 16; ++i) { const float s1 = wave_sum(c[i]), s2 = wave_sum(c[i] * c[i]); if (lane == 0) { red[(wave * 16 + i) * 2] = s1; red[(wave * 16 + i) * 2 + 1] = s2; } }
        __syncthreads();
        const float gg = gng[ch], gb = gnb[ch];
#pragma unroll
        for (int i = 0; i < 16; ++i) {
            const float s1 = red[(wave * 16 + i) * 2] + red[((wave ^ 1) * 16 + i) * 2], s2 = red[(wave * 16 + i) * 2 + 1] + red[((wave ^ 1) * 16 + i) * 2 + 1];
            const float mu = s1 * (1.f / 128.f), var = fmaxf(s2 * (1.f / 128.f) - mu * mu, 0.f);
            const float cn = (c[i] - mu) * rsqrtf(var + EPS) * gg + gb;
            const int tok = t0 + i;
            if (tok < TP) A2[(size_t)(b * TP + tok) * D + 1024 + ch] = (bf16)f2bf(siluf_(cn));
        }
        __syncthreads();
    }
    float* o = a.out + O_SCP;
    for (int i = blockIdx.x * 512 + tid; i < NB * 30 * 1024; i += gridDim.x * 512) { const int ch = i & 1023, j = (i >> 10) % 30, b = (i >> 10) / 30;
        o[i] = bf2f(U[(size_t)(b * TP + TP - 30 + j) * 1024 + ch]); }
}
__device__ __forceinline__ void conv_sample(const Args& a, LAS unsigned char* lds, int tid, int lane, int wave) {
    unsigned char* ws = a.ws; const bf16* U = (const bf16*)(ws + WS_U); bf16* A2 = (bf16*)(ws + WS_A2);
    const float* cw = a.in[I_CWT]; const float* cb = a.in[I_CB]; const float* gng = a.in[I_GNG]; const float* gnb = a.in[I_GNB];
    const float* sc = a.in[I_SC]; float* o = a.out + O_SCS;
    LAS float* red = (LAS float*)lds;
    for (int it = blockIdx.x; it < NS * 2; it += gridDim.x) {
        const int sb = it >> 1, ch = (it & 1) * 512 + tid;
        const float* st = sc + (size_t)sb * 30 * 1024 + ch; float* ot = o + (size_t)sb * 30 * 1024 + ch;
        const float un = bf2f(U[(size_t)(MPROMPT + sb) * 1024 + ch]);
        float s = cb[ch];
#pragma unroll
        for (int j = 0; j < 30; ++j) { const float x = st[j * 1024]; s += cw[j * 1024 + ch] * x; if (j >= 1) ot[(j - 1) * 1024] = x; }
        s += cw[30 * 1024 + ch] * un; ot[29 * 1024] = un;
        const float s1 = wave_sum(s), s2 = wave_sum(s * s);
        if (lane == 0) { red[wave * 2] = s1; red[wave * 2 + 1] = s2; }
        __syncthreads();
        const float a1 = red[wave * 2] + red[(wave ^ 1) * 2], a2 = red[wave * 2 + 1] + red[(wave ^ 1) * 2 + 1];
        const float mu = a1 * (1.f / 128.f), var = fmaxf(a2 * (1.f / 128.f) - mu * mu, 0.f);
        const float cn = (s - mu) * rsqrtf(var + EPS) * gng[ch] + gnb[ch];
        A2[(size_t)(MPROMPT + sb) * D + 1024 + ch] = (bf16)f2bf(siluf_(cn));
        __syncthreads();
    }
}
__device__ __forceinline__ void hgrn_sample(const Args& a, LAS unsigned char* lds, int tid, int lane, int wave) {
    unsigned char* ws = a.ws;
    const float* LF = (const float*)(ws + WS_LF); const bf16* V = (const bf16*)(ws + WS_V); const bf16* Qs = (const bf16*)(ws + WS_QS); const bf16* G = (const bf16*)(ws + WS_G);
    bf16* A2 = (bf16*)(ws + WS_A2); const float* hg = a.in[I_HG]; const float* S0 = a.in[I_SH]; float* So = a.out + O_SHS;
    LAS float* qf = (LAS float*)lds;
    LAS float* red = (LAS float*)(lds + 4096);
    LAS float* r2 = (LAS float*)(lds + 4096 + 8192);
    for (int it = blockIdx.x; it < NS * NH; it += gridDim.x) {
        const int sb = it >> 3, h = it & 7; const size_t row = (size_t)(MPROMPT + sb);
        if (tid < 128) { const size_t idx = row * 1024 + h * 128 + tid; const float f = __expf(LF[idx]);
            qf[tid] = bf2f(Qs[idx]); qf[128 + tid] = f; qf[256 + tid] = 1.f - f; qf[384 + tid] = bf2f(V[idx]); }
        __syncthreads();
        const int v4 = tid & 31, ks = tid >> 5;
        const f32x4 vv = *(const LAS f32x4*)(qf + 384 + 4 * v4);
        const float* sp = S0 + (size_t)it * 16384; float* so = So + (size_t)it * 16384;
        f32x4 o = (f32x4){0.f, 0.f, 0.f, 0.f};
#pragma unroll
        for (int i = 0; i < 8; ++i) { const int k = ks * 8 + i; const f32x4 s = *(const f32x4*)(sp + k * 128 + 4 * v4);
            const f32x4 sn = s * qf[128 + k] + vv * qf[256 + k]; *(f32x4*)(so + k * 128 + 4 * v4) = sn; o += sn * qf[k]; }
        *(LAS f32x4*)(red + ks * 128 + 4 * v4) = o;
        __syncthreads();
        float ov = 0.f;
        if (tid < 128) {
#pragma unroll
            for (int j = 0; j < 16; ++j) ov += red[j * 128 + tid];
            const float ss = wave_sum(ov * ov); if (lane == 0) r2[wave] = ss; }
        __syncthreads();
        if (tid < 128) { const float rstd = rsqrtf((r2[0] + r2[1]) * (1.f / 128.f) + EPS); const size_t idx = row * 1024 + h * 128 + tid;
            A2[row * D + h * 128 + tid] = (bf16)f2bf(ov * rstd * hg[h * 128 + tid] * bf2f(G[idx])); }
        __syncthreads();
    }
}

__device__ __forceinline__ void final_norm(const Args& a, int lane, int wave) {
    RowMap R{a.in[I_XP], a.in[I_XS], a.in[I_META], a.out};
    const f32x4* g = (const f32x4*)a.in[I_GFIN]; const float* part = (const float*)(a.ws + WS_PART);
    for (int m = blockIdx.x * 8 + wave; m < MREAL; m += gridDim.x * 8) {
        float* dst = out_row(R, m); if (!dst) continue;
        f32x4* p = (f32x4*)dst + lane;
        f32x4 v[8];
#pragma unroll
        for (int j = 0; j < 8; ++j) v[j] = p[64 * j];
        if (m >= MAIN_ROWS) {
            for (int s = 0; s < NSLICE; ++s) { const f32x4* q = (const f32x4*)(part + ((size_t)s * 256 + (m - MAIN_ROWS)) * D) + lane;
#pragma unroll
                for (int j = 0; j < 8; ++j) v[j] += q[64 * j]; }
        }
        float ss = 0.f;
#pragma unroll
        for (int j = 0; j < 8; ++j) ss += (v[j][0] * v[j][0] + v[j][1] * v[j][1]) + (v[j][2] * v[j][2] + v[j][3] * v[j][3]);
        const float rstd = rsqrtf(wave_sum(ss) * (1.f / D) + EPS);
#pragma unroll
        for (int j = 0; j < 8; ++j) p[64 * j] = v[j] * rstd * g[lane + 64 * j];
    }
}

#define XB_TMO      128
#define XB_XCNT(j)  (256  + 64 * (j))
#define XB_XSUB(j)  (1280 + 64 * (j))
#define XB_XGEN(j)  (2304 + 64 * (j))
#define XB_TOP      3328
#define XB_TOPGEN   3392
#define XCD_BAR_WORDS 3456
#define XB_SPIN_CAP (1u << 18)

__device__ __forceinline__ unsigned xb_ld(unsigned* p)              { return __hip_atomic_load(p, __ATOMIC_RELAXED, __HIP_MEMORY_SCOPE_AGENT); }
__device__ __forceinline__ unsigned xb_add(unsigned* p, unsigned v) { return __hip_atomic_fetch_add(p, v, __ATOMIC_RELAXED, __HIP_MEMORY_SCOPE_AGENT); }
__device__ __forceinline__ unsigned xb_xcc_id() { return (unsigned)__builtin_amdgcn_s_getreg((3 << 11) | 20) & 0xFu; }
#define XB_SPIN(cond, bar) do { unsigned _sp = 0; while (cond) { __builtin_amdgcn_s_sleep(1); \
    if ((++_sp & 255u) == 0u) { if (xb_ld(&(bar)[XB_TMO])) break; if (_sp > XB_SPIN_CAP) { atomicAdd(&(bar)[XB_TMO], 1u); break; } } } } while (0)

struct XcdBarrier {
    unsigned* bar; unsigned x;
    volatile LAS unsigned* st;
};

__device__ __forceinline__ XcdBarrier xcd_barrier_post(unsigned* bar, volatile LAS unsigned* st) {
    XcdBarrier b; b.bar = bar; b.x = xb_xcc_id(); b.st = st;
    if (threadIdx.x == 0) (void)xb_add(&bar[XB_XCNT(b.x)], 1u);
    return b;
}
__device__ __forceinline__ void xcd_barrier_complete(unsigned* bar, unsigned x, unsigned& nloc, unsigned& nx) {
    const unsigned G = gridDim.x * gridDim.y * gridDim.z;
    unsigned sum, cnt, mine, sp = 0u;
    for (;;) {
        sum = 0u; cnt = 0u; mine = 0u;
#pragma unroll
        for (unsigned j = 0; j < 16; ++j) { const unsigned c = xb_ld(&bar[XB_XCNT(j)]); sum += c; cnt += (c > 0u) ? 1u : 0u; mine = (j == x) ? c : mine; }
        if (sum == G) break;
        __builtin_amdgcn_s_sleep(1);
        if ((++sp & 255u) == 0u) { if (xb_ld(&bar[XB_TMO])) break; if (sp > XB_SPIN_CAP) { atomicAdd(&bar[XB_TMO], 1u); break; } }
    }
    nloc = mine > 0u ? mine : 1u; nx = cnt > 0u ? cnt : 1u;
}

__device__ __forceinline__ void xcd_barrier(const XcdBarrier& b) {
    asm volatile("s_waitcnt vmcnt(0)" ::: "memory");
    __syncthreads();
    if (threadIdx.x == 0) {
        unsigned* bar = b.bar;
        __builtin_amdgcn_s_waitcnt(0);
        unsigned nloc = b.st[0], nx = b.st[1];
        if (nloc == 0u) { xcd_barrier_complete(bar, b.x, nloc, nx); b.st[0] = nloc; b.st[1] = nx; }
        const unsigned old = xb_add(&bar[XB_XSUB(b.x)], 1u);
        const unsigned gen = old / nloc;
        if (old + 1u == (gen + 1u) * nloc) {
            __builtin_amdgcn_fence(__ATOMIC_RELEASE, "agent");
            asm volatile("s_waitcnt vmcnt(0)" ::: "memory");
            const unsigned og = xb_add(&bar[XB_TOP], 1u);
            const unsigned tg = og / nx;
            if (og + 1u == (tg + 1u) * nx) xb_add(&bar[XB_TOPGEN], 1u);
            else XB_SPIN(xb_ld(&bar[XB_TOPGEN]) == tg, bar);
            __builtin_amdgcn_fence(__ATOMIC_ACQUIRE, "agent");
            xb_add(&bar[XB_XGEN(b.x)], 1u);
            asm volatile("s_waitcnt vmcnt(0)" ::: "memory");
        } else {
            XB_SPIN(xb_ld(&bar[XB_XGEN(b.x)]) == gen, bar);
            __builtin_amdgcn_fence(__ATOMIC_ACQUIRE, "agent");
            asm volatile("s_waitcnt vmcnt(0)" ::: "memory");
        }
    }
    __syncthreads();
}

constexpr int NPHASE = 9;
#ifndef REP_P0
#define REP_P0 1
#endif
#ifndef REP_G1
#define REP_G1 1
#endif
#ifndef REP_P2
#define REP_P2 1
#endif
#ifndef REP_SYNC
#define REP_SYNC 1
#endif
__global__ void __launch_bounds__(512, 2) hymba_fwd(Args args) {
    extern __shared__ __attribute__((aligned(16))) unsigned char lds_raw[];
    LAS unsigned char* lds = (LAS unsigned char*)lds_raw;
    cg::grid_group grid = cg::this_grid();
    const int tid = threadIdx.x, lane = tid & 63, wave = __builtin_amdgcn_readfirstlane(tid >> 6);
    unsigned char* ws = args.ws;
    const int lo = args.ph_lo, hi = args.ph_hi;
#define IN(k) (lo <= (k) && (k) < hi)
#define SEAM(k) do { if (IN(k) && IN((k) + 1)) { for (int rep_ = 0; rep_ < REP_SYNC; ++rep_) xcd_barrier(bar); } } while (0)
    RowMap R{args.in[I_XP], args.in[I_XS], args.in[I_META], args.out};
    if (lo < 0) grid.sync();
    if (tid < 64) ((LAS unsigned*)(lds + LDS_MISC))[tid] = 0u;
    __syncthreads();
    XcdBarrier bar; bar.bar = (unsigned*)(ws + WS_BAR); bar.x = 0; bar.st = nullptr;
    if (hi - lo > 1) bar = xcd_barrier_post((unsigned*)(ws + WS_BAR), (volatile LAS unsigned*)(lds + LDS_MISC) + 8);
    if (IN(0)) { for (int rep = 0; rep < REP_P0; ++rep) p0_prologue(args, lds, tid, lane, wave); }
    SEAM(0);
    if (IN(1)) for (int rep = 0; rep < REP_G1; ++rep) {
        pg8::Gemm g{(const bf16*)(ws + WS_XN), (const bf16*)(ws + WS_WIN), MP, NIN, D}; pg8::StaticOrder S; S.init(MP, NIN, gridDim.x, (int)blockIdx.x, D);
        EpiIn E{(bf16*)(ws + WS_QS), (float*)(ws + WS_LF), (bf16*)(ws + WS_V), (bf16*)(ws + WS_G), (bf16*)(ws + WS_U), (const float*)(ws + WS_CTL)};
        pg8::gemm_phase<EpiIn, pg8::StaticOrder, true, true>(lds, g, S, E);
    }
    SEAM(1);
    if (IN(2)) for (int rep = 0; rep < REP_P2; ++rep) { hgrn_local(args, lds, tid, lane, wave); conv_prompt(args, lds, tid, lane, wave); conv_sample(args, lds, tid, lane, wave); hgrn_sample(args, lds, tid, lane, wave); }
    SEAM(2);
    if (IN(3)) { hgrn_scan(args, tid); }
    SEAM(3);
    if (IN(4)) for (int rep = 0; rep < REP_P2; ++rep) { hgrn_out(args, lds, tid, lane, wave); }
    SEAM(4);
    if (IN(5)) {
        pg8::Gemm g{(const bf16*)(ws + WS_A2), (const bf16*)(ws + WS_WOUT), MP, D, D}; pg8::StaticOrder S; S.init(MP, D, gridDim.x, (int)blockIdx.x, D);
        EpiOut E{R, (bf16*)(ws + WS_XN), args.in[I_GFFN], (float*)(ws + WS_CTL) + 16384};
        pg8::gemm_phase<EpiOut, pg8::StaticOrder, true, true>(lds, g, S, E);
    }
    SEAM(5);
    if (IN(6)) {
        pg8::Gemm g{(const bf16*)(ws + WS_XN), (const bf16*)(ws + WS_WGU), MP, 2 * FF, D}; pg8::StaticOrder S; S.init(MP, 2 * FF, gridDim.x, (int)blockIdx.x, D);
        EpiGU E{(const float*)(ws + WS_CTL) + 16384, (bf16*)(ws + WS_A4)};
        pg8::gemm_phase<EpiGU, pg8::StaticOrder, true, true>(lds, g, S, E);
    }
    SEAM(6);
    if (IN(7)) {
        pg8::Gemm g{(const bf16*)(ws + WS_A4), (const bf16*)(ws + WS_WD), MP, D, FF}; SplitOrder S; S.init(MAIN_ROWS, D, gridDim.x, (int)blockIdx.x, FF);
        EpiDown E{R, (float*)(ws + WS_PART)};
        pg8::gemm_phase<EpiDown, SplitOrder, true, true>(lds, g, S, E);
    }
    SEAM(7);
    if (IN(8)) { final_norm(args, lane, wave); }
#undef IN
#undef SEAM
}

#ifndef MK_N_LAUNCHES
#define MK_N_LAUNCHES 1
#endif
extern "C" void kernel_launch(void* const* d_in, const int* in_sizes, int n_in, void* d_out, int out_size, void* d_ws, size_t ws_size, hipStream_t stream) {
    static int grid = 0;
    if (grid == 0) {
        if (n_in != 19 || (size_t)out_size != O_END || ws_size < WS_END) { fprintf(stderr, "kernel_launch: unexpected shapes: n_in %d out %d ws %zu (need %zu)\n", n_in, out_size, ws_size, (size_t)WS_END); grid = -1; return; }
        int dev = 0, cus = 0, per_cu = 0;
        if (hipGetDevice(&dev) != hipSuccess || hipDeviceGetAttribute(&cus, hipDeviceAttributeMultiprocessorCount, dev) != hipSuccess) { grid = -1; return; }
        if (hipFuncSetAttribute((const void*)hymba_fwd, hipFuncAttributeMaxDynamicSharedMemorySize, LDS_BYTES) != hipSuccess) { fprintf(stderr, "kernel_launch: hipFuncSetAttribute failed\n"); grid = -1; return; }
        if (hipOccupancyMaxActiveBlocksPerMultiprocessor(&per_cu, (const void*)hymba_fwd, 512, LDS_BYTES) != hipSuccess || per_cu < 1) { fprintf(stderr, "kernel_launch: occupancy query failed (%d)\n", per_cu); (void)hipGetLastError(); grid = -1; return; }
        grid = cus * per_cu;
        fprintf(stderr, "kernel_launch: grid %d (%d CUs x %d)\n", grid, cus, per_cu);
    }
    if (grid < 0) return;
    if (hipMemsetAsync((char*)d_ws + WS_BAR, 0, BAR_BYTES, stream) != hipSuccess) { fprintf(stderr, "kernel_launch: memset failed\n"); return; }
    Args a{};
    for (int i = 0; i < 19; ++i) a.in[i] = (const float*)d_in[i];
    a.out = (float*)d_out; a.ws = (unsigned char*)d_ws;
#if MK_N_LAUNCHES == 1
    a.ph_lo = 0; a.ph_hi = NPHASE;
    void* kargs[] = {&a};
    hipError_t e = hipLaunchCooperativeKernel((const void*)hymba_fwd, dim3(grid), dim3(512), kargs, LDS_BYTES, stream);
    if (e != hipSuccess) fprintf(stderr, "kernel_launch: cooperative launch failed: %s (grid %d)\n", hipGetErrorString(e), grid);
#else
    for (int p = 0; p < NPHASE; ++p) { a.ph_lo = p; a.ph_hi = p + 1; hipLaunchKernelGGL(hymba_fwd, dim3(grid), dim3(512), LDS_BYTES, stream, a); }
#endif
}
```

```cpp
#include <hip/hip_runtime.h>
#include <hip/hip_cooperative_groups.h>
#include <cstdio>
#include <cstdint>
namespace cg = cooperative_groups;
namespace pg8 {
#define PG8_LAS __attribute__((address_space(3)))
typedef unsigned short bf16_t;
typedef short bf16x8 __attribute__((ext_vector_type(8)));
typedef float f32x4 __attribute__((ext_vector_type(4)));
typedef unsigned u32x4 __attribute__((ext_vector_type(4)));
constexpr int BM = 256, BK = 64, HALF = 128, HTB = HALF * BK * 2  , STAGE_BYTES = 8 * HTB, NXCD = 8, WGM = 8;

__host__ __device__ __forceinline__ int lds_byte(int r, int c) { const int st = (r >> 4) * 2 + (c >> 5), rr = r & 15, cc = c & 31, ob = rr * 64 + cc * 2; return st * 1024 + (ob ^ (((ob >> 9) & 1) << 5)); }
__host__ __device__ __forceinline__ void stage_rc(int b, int& R, int& C) { const int st = b / 1024, sb = b % 1024, swz = sb ^ (((sb >> 9) & 1) << 5); R = (st >> 1) * 16 + swz / 64; C = (st & 1) * 32 + (swz % 64) / 2; }
__host__ __device__ __forceinline__ int perm32(int rho) { const int n = rho >> 4, i = rho & 15; return 8 * (i >> 2) + 4 * n + (i & 3); }

struct Unit { int pm, pn, k0, nt; };
struct Gemm { const bf16_t* A; const bf16_t* Bt; int M, N, K; };

struct StaticOrder {
    int nM, nN, nwg, G, c, ntf;
    __host__ __device__ void init(int M, int N, int G_, int c_, int K_) { nM = M / BM; nN = N / BM; nwg = nM * nN; G = G_; c = c_; ntf = K_ / BK; }
    __host__ __device__ bool next(int i, Unit& u) const {
        const long L = (long)i * G + c; if (L >= nwg) return false;
        int wgid = (int)L; { const int q = nwg / NXCD, r = nwg % NXCD, xcd = wgid % NXCD, off = wgid / NXCD; wgid = (xcd < r ? xcd * (q + 1) : r * (q + 1) + (xcd - r) * q) + off; }
        const int nig = WGM * nN, gid = wgid / nig, fm = gid * WGM, gsz = (nM - fm) < WGM ? (nM - fm) : WGM;
        u.pm = fm + ((wgid % nig) % gsz); u.pn = (wgid % nig) / gsz; u.k0 = 0; u.nt = ntf; return true;
    }
    __device__ __forceinline__ void a_ready(const Unit&) const {}
    __device__ __forceinline__ void done(const Unit&) const {}
};
__device__ __forceinline__ unsigned cvt_pk_bf16(float lo, float hi) { unsigned r; asm volatile("v_cvt_pk_bf16_f32 %0, %1, %2" : "=v"(r) : "v"(lo), "v"(hi)); return r; }
template <class Epi, class Sched, bool ALIGN_EPI = false, bool SP2 = false>
__device__ __forceinline__ void gemm_phase(PG8_LAS unsigned char* lds, const Gemm g, const Sched& S, const Epi& E) {
    const int tid = threadIdx.x, wid = __builtin_amdgcn_readfirstlane(tid >> 6), lane = tid & 63, wr = wid >> 2, wc = wid & 3, fr = lane & 15, fq = lane >> 4;
    const int K = g.K;
    unsigned voffA[2], voffB[2];
#pragma unroll
    for (int i = 0; i < 2; ++i) { int R, C; stage_rc(tid * 16 + i * 8192, R, C); const int Rb = Epi::PERM ? ((R & ~31) + perm32(R & 31)) : R;
        voffA[i] = (unsigned)(R * K + C) * 2u; voffB[i] = (unsigned)(Rb * K + C) * 2u; }
    const size_t kstep = (size_t)(BK * 2);
    const size_t hstep = (size_t)HALF * K * 2;
    const size_t tstep = 2 * hstep;
    const unsigned ldsw = (unsigned)wid * 1024u;
    const int aoff = lds_byte(wr * 64 + fr, fq * 8), boff = lds_byte(wc * 32 + fr, fq * 8);
#define PG8_SA(b, h) (((b) * 2 + (h)) * HTB)
#define PG8_SB(b, h) ((4 + (b) * 2 + (h)) * HTB)
#define PG8_STAGE(bufoff, gbase, voff) do { _Pragma("unroll") for (int _i = 0; _i < 2; ++_i) \
        __builtin_amdgcn_global_load_lds((const unsigned*)((const char*)(gbase) + (voff)[_i]), (PG8_LAS unsigned*)(lds + (bufoff) + ldsw + _i * 8192), 16, 0, 0); } while (0)
#define PG8_LDA(dst, b, h) do { _Pragma("unroll") for (int m = 0; m < 4; ++m) _Pragma("unroll") for (int k = 0; k < 2; ++k) dst[m][k] = *(const PG8_LAS bf16x8*)(lds + PG8_SA(b, h) + aoff + m * 2048 + k * 1024); } while (0)
#define PG8_LDB(dst, b, h) do { _Pragma("unroll") for (int n = 0; n < 2; ++n) _Pragma("unroll") for (int k = 0; k < 2; ++k) dst[n][k] = *(const PG8_LAS bf16x8*)(lds + PG8_SB(b, h) + boff + n * 2048 + k * 1024); } while (0)
#define PG8_MMA(ai, bj, At, Bt) do { __builtin_amdgcn_s_setprio(1); _Pragma("unroll") for (int m = 0; m < 4; ++m) _Pragma("unroll") for (int n = 0; n < 2; ++n) _Pragma("unroll") for (int k = 0; k < 2; ++k) \
        acc[ai][bj][m][n] = __builtin_amdgcn_mfma_f32_16x16x32_bf16(Bt[n][k], At[m][k], acc[ai][bj][m][n], 0, 0, 0); __builtin_amdgcn_s_setprio(0); } while (0)
#define PG8_WAIT_V(n) asm volatile("s_waitcnt vmcnt(" #n ")" ::: "memory")
#define PG8_WAIT_L(n) asm volatile("s_waitcnt lgkmcnt(" #n ")" ::: "memory")
#define PG8_BAR __builtin_amdgcn_s_barrier()
#define PG8_SCHED __builtin_amdgcn_sched_barrier(0)
    Unit cur, nxt; int ui = 0;
    if (!S.next(0, cur)) return;
    f32x4 acc[2][2][4][2];
#pragma unroll
    for (int a = 0; a < 2; ++a)
#pragma unroll
        for (int b = 0; b < 2; ++b)
#pragma unroll
            for (int m = 0; m < 4; ++m)
#pragma unroll
                for (int n = 0; n < 2; ++n) acc[a][b][m][n] = (f32x4){0.f, 0.f, 0.f, 0.f};
    bf16x8 At[4][2], B0[2][2], B1[2][2];
    const char* cA = (const char*)g.A + (size_t)cur.pm * tstep + (size_t)cur.k0 * 2; const char* cB = (const char*)g.Bt + (size_t)cur.pn * tstep + (size_t)cur.k0 * 2;
    S.a_ready(cur);
    if constexpr (SP2) {
        PG8_STAGE(PG8_SB(0, 0), cB, voffB); PG8_STAGE(PG8_SB(0, 1), cB + hstep, voffB); PG8_STAGE(PG8_SA(0, 0), cA, voffA); PG8_STAGE(PG8_SA(0, 1), cA + hstep, voffA);
        if (wr == 1) PG8_BAR;
        PG8_WAIT_V(2); PG8_BAR;
        PG8_STAGE(PG8_SB(1, 0), cB + kstep, voffB); PG8_STAGE(PG8_SA(1, 0), cA + kstep, voffA); PG8_STAGE(PG8_SB(1, 1), cB + hstep + kstep, voffB);
        PG8_WAIT_V(6); PG8_BAR;
    } else {
        PG8_STAGE(PG8_SB(0, 0), cB, voffB); PG8_STAGE(PG8_SA(0, 0), cA, voffA); PG8_STAGE(PG8_SB(0, 1), cB + hstep, voffB); PG8_STAGE(PG8_SA(0, 1), cA + hstep, voffA);
        if (wr == 1) PG8_BAR;
        PG8_WAIT_V(4); PG8_BAR;
        PG8_STAGE(PG8_SB(1, 0), cB + kstep, voffB); PG8_STAGE(PG8_SA(1, 0), cA + kstep, voffA); PG8_STAGE(PG8_SB(1, 1), cB + hstep + kstep, voffB);
        PG8_WAIT_V(6); PG8_BAR;
    }
    for (;;) {
        const bool has_next = S.next(ui + 1, nxt);
        const char* nA = has_next ? (const char*)g.A + (size_t)nxt.pm * tstep + (size_t)nxt.k0 * 2 : cA; const char* nB = has_next ? (const char*)g.Bt + (size_t)nxt.pn * tstep + (size_t)nxt.k0 * 2 : cB;
        const int nt = cur.nt;
        for (int t = 0; t < nt; t += 2) {
            const bool last = (t == nt - 2);
            const char* a1 = cA + (size_t)(t + 1) * kstep;
            const char* a2 = last ? nA : cA + (size_t)(t + 2) * kstep; const char* b2 = last ? nB : cB + (size_t)(t + 2) * kstep;
            const char* a3 = a2 + kstep; const char* b3 = b2 + kstep;
            if (last && has_next) S.a_ready(nxt);
            if constexpr (SP2) {
            PG8_LDB(B0, 0, 0); PG8_LDB(B1, 0, 1); PG8_SCHED; PG8_LDA(At, 0, 0); PG8_STAGE(PG8_SA(1, 1), a1 + hstep, voffA);
            PG8_WAIT_V(8); PG8_WAIT_L(0); PG8_BAR; PG8_MMA(0, 0, At, B0); PG8_MMA(0, 1, At, B1); PG8_BAR; PG8_SCHED;
            PG8_LDA(At, 0, 1); PG8_STAGE(PG8_SB(0, 0), b2, voffB); PG8_STAGE(PG8_SB(0, 1), b2 + hstep, voffB); PG8_STAGE(PG8_SA(0, 0), a2, voffA);
            PG8_WAIT_V(8); PG8_WAIT_L(0); PG8_BAR; PG8_MMA(1, 0, At, B0); PG8_MMA(1, 1, At, B1); PG8_BAR; PG8_SCHED;
            PG8_LDB(B0, 1, 0); PG8_LDB(B1, 1, 1); PG8_SCHED; PG8_LDA(At, 1, 0); PG8_STAGE(PG8_SA(0, 1), a2 + hstep, voffA);
            PG8_WAIT_V(8); PG8_WAIT_L(0); PG8_BAR; PG8_MMA(0, 0, At, B0); PG8_MMA(0, 1, At, B1); PG8_BAR; PG8_SCHED;
            PG8_LDA(At, 1, 1); PG8_STAGE(PG8_SB(1, 0), b3, voffB); PG8_STAGE(PG8_SB(1, 1), b3 + hstep, voffB); PG8_STAGE(PG8_SA(1, 0), a3, voffA);
            PG8_WAIT_V(8); PG8_WAIT_L(0); PG8_BAR; PG8_MMA(1, 0, At, B0); PG8_MMA(1, 1, At, B1); PG8_BAR; PG8_SCHED;
            } else {
            PG8_LDB(B0, 0, 0); PG8_SCHED; PG8_LDA(At, 0, 0); PG8_STAGE(PG8_SA(1, 1), a1 + hstep, voffA);
            PG8_WAIT_L(8); PG8_BAR; PG8_WAIT_L(0); PG8_MMA(0, 0, At, B0); PG8_BAR; PG8_SCHED;
            PG8_LDB(B1, 0, 1); PG8_STAGE(PG8_SB(0, 0), b2, voffB);
            PG8_BAR; PG8_WAIT_L(0); PG8_MMA(0, 1, At, B1); PG8_BAR;
            PG8_LDA(At, 0, 1); PG8_STAGE(PG8_SA(0, 0), a2, voffA);
            PG8_BAR; PG8_WAIT_L(0); PG8_MMA(1, 0, At, B0); PG8_BAR; PG8_SCHED;
            PG8_STAGE(PG8_SB(0, 1), b2 + hstep, voffB);
            PG8_WAIT_V(6); PG8_BAR; PG8_MMA(1, 1, At, B1); PG8_BAR;
            PG8_LDB(B0, 1, 0); PG8_SCHED; PG8_LDA(At, 1, 0); PG8_STAGE(PG8_SA(0, 1), a2 + hstep, voffA);
            PG8_WAIT_L(8); PG8_BAR; PG8_WAIT_L(0); PG8_MMA(0, 0, At, B0); PG8_BAR; PG8_SCHED;
            PG8_LDB(B1, 1, 1); PG8_STAGE(PG8_SB(1, 0), b3, voffB);
            PG8_BAR; PG8_WAIT_L(0); PG8_MMA(0, 1, At, B1); PG8_BAR;
            PG8_LDA(At, 1, 1); PG8_STAGE(PG8_SA(1, 0), a3, voffA);
            PG8_BAR; PG8_WAIT_L(0); PG8_MMA(1, 0, At, B0); PG8_BAR; PG8_SCHED;
            PG8_STAGE(PG8_SB(1, 1), b3 + hstep, voffB);
            PG8_WAIT_V(6); PG8_BAR; PG8_MMA(1, 1, At, B1); PG8_BAR;
            }
        }
        if constexpr (ALIGN_EPI) { if (wr == 0) PG8_BAR; }
        if constexpr (!Epi::AFTER_DRAIN) { E(acc, cur, wr, wc, fr, fq); S.done(cur); }
        if (!has_next) break;
#pragma unroll
        for (int a = 0; a < 2; ++a)
#pragma unroll
            for (int b = 0; b < 2; ++b)
#pragma unroll
                for (int m = 0; m < 4; ++m)
#pragma unroll
                    for (int n = 0; n < 2; ++n) acc[a][b][m][n] = (f32x4){0.f, 0.f, 0.f, 0.f};
        cur = nxt; cA = nA; cB = nB; ++ui;
        if constexpr (ALIGN_EPI) { if (wr == 1) PG8_BAR; }
    }
    PG8_WAIT_V(0);
    if constexpr (!ALIGN_EPI) { if (wr == 0) PG8_BAR; }
    PG8_BAR;
    if constexpr (Epi::AFTER_DRAIN) { E.fused(acc, cur, wr, wc, fr, fq, lds, wid, lane); S.done(cur); }
#undef PG8_SA
#undef PG8_SB
#undef PG8_STAGE
#undef PG8_LDA
#undef PG8_LDB
#undef PG8_MMA
#undef PG8_WAIT_V
#undef PG8_WAIT_L
#undef PG8_BAR
#undef PG8_SCHED
}
}

constexpr int D = 2048, NB = 4, SEQ = 2048, NMETA = 16, TP = SEQ + NMETA, MPROMPT = NB * TP, NS = 128, MREAL = MPROMPT + NS, MP = 8448;
constexpr int AW = 1024, NH = 8, NCHUNK = 33, CW = 31, FF = 5632, NIN = 6144, NITEM = NB * NH * NCHUNK;
constexpr float EPS = 1e-6f;
static_assert(MP % 256 == 0 && MP >= MREAL, "row padding");

constexpr size_t MiB = 1u << 20;
constexpr size_t WS_CTL = 0;
constexpr size_t WS_WIN = 1 * MiB, WS_WOUT = 25 * MiB, WS_WGU = 33 * MiB, WS_WD = 77 * MiB;
constexpr size_t WS_XN = 99 * MiB;
constexpr size_t WS_A2 = 132 * MiB;
constexpr size_t WS_QS = 165 * MiB, WS_V = WS_QS + 16896 * 1024, WS_G = WS_V + 16896 * 1024, WS_U = WS_G + 16896 * 1024;
constexpr size_t WS_LF = 231 * MiB;
constexpr size_t WS_SB = 264 * MiB;
constexpr size_t WS_AC = 297 * MiB;
constexpr size_t WS_A4 = 165 * MiB;
constexpr size_t WS_END = 298 * MiB;
constexpr size_t WS_PART = WS_WIN;
static_assert(WS_A4 + (size_t)MP * FF * 2 <= WS_AC && WS_SB + (size_t)NITEM * 32768 <= WS_AC && WS_LF + (size_t)MP * 1024 * 4 <= WS_SB, "ws map");

constexpr int LDS_BYTES = 147456, LDS_MISC = 131072;
constexpr size_t WS_BAR = 256 * 1024, BAR_BYTES = 16384;
#define LAS __attribute__((address_space(3)))
typedef unsigned short bf16;
typedef unsigned v4u __attribute__((ext_vector_type(4)));
typedef unsigned v2u __attribute__((ext_vector_type(2)));
typedef float f32x4 __attribute__((ext_vector_type(4)));
typedef short bf16x8 __attribute__((ext_vector_type(8)));

__device__ __forceinline__ unsigned f2bf(float f) { unsigned u = __builtin_bit_cast(unsigned, f); return (u + 0x7fffu + ((u >> 16) & 1u)) >> 16; }
__device__ __forceinline__ unsigned pk2(float lo, float hi) { return f2bf(lo) | (f2bf(hi) << 16); }
__device__ __forceinline__ float bf2f(unsigned b) { return __builtin_bit_cast(float, b << 16); }
__device__ __forceinline__ float bflo(unsigned w) { return __builtin_bit_cast(float, w << 16); }
__device__ __forceinline__ float bfhi(unsigned w) { return __builtin_bit_cast(float, w & 0xffff0000u); }
__device__ __forceinline__ float sigmoidf_(float x) { return 1.f / (1.f + __expf(-x)); }
__device__ __forceinline__ float siluf_(float x) { return x / (1.f + __expf(-x)); }
__device__ __forceinline__ float wave_sum(float v) {
#pragma unroll
    for (int o = 1; o < 64; o <<= 1) v += __shfl_xor(v, o);
    return v;
}

struct Args { const float* in[19]; float* out; unsigned char* ws; int ph_lo, ph_hi; };
enum { I_XP = 0, I_XS, I_SH, I_SC, I_META, I_GMIX, I_WIN, I_LB, I_HG, I_CWT, I_CB, I_GNG, I_GNB, I_WOUT, I_GFFN, I_WG, I_WU, I_WD, I_GFIN };
constexpr size_t O_YP = 0, O_YS = (size_t)NB * SEQ * D, O_SHP = O_YS + (size_t)NS * D, O_SCP = O_SHP + (size_t)NB * NH * 128 * 128,
                 O_SHS = O_SCP + (size_t)NB * 30 * 1024, O_SCS = O_SHS + (size_t)NS * NH * 128 * 128, O_END = O_SCS + (size_t)NS * 30 * 1024;

struct RowMap { const float* xp; const float* xs; const float* meta; float* out; };
__device__ __forceinline__ const float* src_row(const RowMap& R, int r) {
    if (r >= MPROMPT) return R.xs + (size_t)(r - MPROMPT) * D;
    const int b = r / TP, t = r - b * TP;
    return t < NMETA ? R.meta + (size_t)t * D : R.xp + ((size_t)b * SEQ + (t - NMETA)) * D;
}
__device__ __forceinline__ float* out_row(const RowMap& R, int r) {
    if (r >= MPROMPT) return R.out + O_YS + (size_t)(r - MPROMPT) * D;
    const int b = r / TP, t = r - b * TP;
    return t < NMETA ? nullptr : R.out + O_YP + ((size_t)b * SEQ + (t - NMETA)) * D;
}

using pg8::Unit;
struct EpiIn {
    static constexpr bool PERM = true, AFTER_DRAIN = false;
    bf16* Qs; float* LF; bf16* V; bf16* G; bf16* U; const float* lbv;
    __device__ __forceinline__ void operator()(const f32x4 (&acc)[2][2][4][2], const Unit& u, int wr, int wc, int fr, int fq) const {
        const int row0 = u.pm * 256 + wr * 64 + fr;
        if (u.pn >= 16) {
            const int c0 = (u.pn - 16) * 128 + wc * 32 + 8 * fq;
#pragma unroll
            for (int ai = 0; ai < 2; ++ai)
#pragma unroll
                for (int m = 0; m < 4; ++m) {
                    const size_t row = (size_t)(row0 + ai * 128 + m * 16);
                    float o[8];
#pragma unroll
                    for (int n = 0; n < 2; ++n)
#pragma unroll
                        for (int j = 0; j < 4; ++j) o[n * 4 + j] = acc[ai][0][m][n][j] * sigmoidf_(acc[ai][1][m][n][j]);
                    v4u w; w.x = pg8::cvt_pk_bf16(o[0], o[1]); w.y = pg8::cvt_pk_bf16(o[2], o[3]); w.z = pg8::cvt_pk_bf16(o[4], o[5]); w.w = pg8::cvt_pk_bf16(o[6], o[7]);
                    *(v4u*)(U + row * 1024 + c0) = w;
                }
            return;
        }
        const int kind = u.pn >> 2, cb = (u.pn & 3) * 256 + wc * 32 + 8 * fq;
        if (kind == 1) {
            f32x4 lb[2][2];
#pragma unroll
            for (int bj = 0; bj < 2; ++bj)
#pragma unroll
                for (int n = 0; n < 2; ++n) lb[bj][n] = *(const f32x4*)(lbv + cb + bj * 128 + 4 * n);
#pragma unroll
            for (int ai = 0; ai < 2; ++ai)
#pragma unroll
                for (int m = 0; m < 4; ++m) {
                    const size_t row = (size_t)(row0 + ai * 128 + m * 16);
#pragma unroll
                    for (int bj = 0; bj < 2; ++bj)
#pragma unroll
                        for (int n = 0; n < 2; ++n) {
                            f32x4 o;
#pragma unroll
                            for (int j = 0; j < 4; ++j) { const float l = lb[bj][n][j]; o[j] = __logf(l + (1.f - l) * sigmoidf_(acc[ai][bj][m][n][j])); }
                            *(f32x4*)(LF + row * 1024 + cb + bj * 128 + 4 * n) = o;
                        }
                }
            return;
        }
        bf16* dst = Qs + (size_t)(kind == 0 ? 0 : kind - 1) * ((size_t)MP * 1024);
#pragma unroll
        for (int ai = 0; ai < 2; ++ai)
#pragma unroll
            for (int m = 0; m < 4; ++m) {
                const size_t row = (size_t)(row0 + ai * 128 + m * 16);
#pragma unroll
                for (int bj = 0; bj < 2; ++bj) {
                    float o[8];
#pragma unroll
                    for (int n = 0; n < 2; ++n)
#pragma unroll
                        for (int j = 0; j < 4; ++j) { const float x = acc[ai][bj][m][n][j]; o[n * 4 + j] = (kind == 2) ? x : siluf_(x); }
                    v4u w; w.x = pg8::cvt_pk_bf16(o[0], o[1]); w.y = pg8::cvt_pk_bf16(o[2], o[3]); w.z = pg8::cvt_pk_bf16(o[4], o[5]); w.w = pg8::cvt_pk_bf16(o[6], o[7]);
                    *(v4u*)(dst + row * 1024 + cb + bj * 128) = w;
                }
            }
    }
};

struct EpiOut {
    static constexpr bool PERM = true, AFTER_DRAIN = false;
    RowMap R; bf16* A3; const float* gffn; float* rowss;
    __device__ __forceinline__ void operator()(const f32x4 (&acc)[2][2][4][2], const Unit& u, int wr, int wc, int fr, int fq) const {
        const int row0 = u.pm * 256 + wr * 64 + fr, c0 = u.pn * 256 + wc * 32 + 8 * fq;
        f32x4 gv[2][2];
#pragma unroll
        for (int bj = 0; bj < 2; ++bj)
#pragma unroll
            for (int n = 0; n < 2; ++n) gv[bj][n] = *(const f32x4*)(gffn + c0 + bj * 128 + 4 * n);
#pragma unroll
        for (int ai = 0; ai < 2; ++ai)
#pragma unroll
            for (int m = 0; m < 4; ++m) {
                const int row = row0 + ai * 128 + m * 16;
                float ss = 0.f;
                if (row < MREAL) {
                    const float* src = src_row(R, row) + c0; float* dst = out_row(R, row);
#pragma unroll
                    for (int bj = 0; bj < 2; ++bj) {
                        f32x4 h[2];
#pragma unroll
                        for (int n = 0; n < 2; ++n) { h[n] = acc[ai][bj][m][n] + *(const f32x4*)(src + bj * 128 + 4 * n);
                            ss += (h[n][0] * h[n][0] + h[n][1] * h[n][1]) + (h[n][2] * h[n][2] + h[n][3] * h[n][3]);
                            if (dst) *(f32x4*)(dst + c0 + bj * 128 + 4 * n) = h[n]; }
                        const f32x4 a = h[0] * gv[bj][0], b = h[1] * gv[bj][1];
                        v4u w; w.x = pg8::cvt_pk_bf16(a[0], a[1]); w.y = pg8::cvt_pk_bf16(a[2], a[3]); w.z = pg8::cvt_pk_bf16(b[0], b[1]); w.w = pg8::cvt_pk_bf16(b[2], b[3]);
                        *(v4u*)(A3 + (size_t)row * D + c0 + bj * 128) = w;
                    }
                }
                ss += __shfl_xor(ss, 16); ss += __shfl_xor(ss, 32);
                if (fq == 0 && row < MREAL) atomicAdd(rowss + row, ss);
            }
    }
};

struct EpiGU {
    static constexpr bool PERM = true, AFTER_DRAIN = false;
    const float* rowss; bf16* A4;
    __device__ __forceinline__ void operator()(const f32x4 (&acc)[2][2][4][2], const Unit& u, int wr, int wc, int fr, int fq) const {
        const int row0 = u.pm * 256 + wr * 64 + fr, c0 = u.pn * 128 + wc * 32 + 8 * fq;
#pragma unroll
        for (int ai = 0; ai < 2; ++ai)
#pragma unroll
            for (int m = 0; m < 4; ++m) {
                const int row = row0 + ai * 128 + m * 16;
                const float rstd = rsqrtf(rowss[row] * (1.f / D) + EPS);
                float o[8];
#pragma unroll
                for (int n = 0; n < 2; ++n)
#pragma unroll
                    for (int j = 0; j < 4; ++j) o[n * 4 + j] = siluf_(acc[ai][0][m][n][j] * rstd) * (acc[ai][1][m][n][j] * rstd);
                v4u w; w.x = pg8::cvt_pk_bf16(o[0], o[1]); w.y = pg8::cvt_pk_bf16(o[2], o[3]); w.z = pg8::cvt_pk_bf16(o[4], o[5]); w.w = pg8::cvt_pk_bf16(o[6], o[7]);
                *(v4u*)(A4 + (size_t)row * FF + c0) = w;
            }
    }
};

constexpr int MAIN_ROWS = 8192, NSLICE = 11, SLICE_NT = 8;
static_assert(NSLICE * SLICE_NT * 64 == FF && MAIN_ROWS + 256 == MP, "down-proj split");
struct SplitOrder : pg8::StaticOrder {
    __host__ __device__ bool next(int i, Unit& u) const {
        const long L = (long)i * G + c;
        if (L < nwg) return pg8::StaticOrder::next(i, u);
        const int j = (int)(L - nwg); if (j >= NSLICE * (D / 256)) return false;
        u.pm = MAIN_ROWS / 256; u.pn = j & 7; u.k0 = (j >> 3) * (SLICE_NT * 64); u.nt = SLICE_NT; return true;
    }
};
struct EpiDown {
    static constexpr bool PERM = true, AFTER_DRAIN = false;
    RowMap R; float* part;
    __device__ __forceinline__ void operator()(const f32x4 (&acc)[2][2][4][2], const Unit& u, int wr, int wc, int fr, int fq) const {
        const int c0 = u.pn * 256 + wc * 32 + 8 * fq;
        if (u.nt == SLICE_NT) {
            float* pb = part + ((size_t)(u.k0 / (SLICE_NT * 64)) * 256 + wr * 64 + fr) * D + c0;
#pragma unroll
            for (int ai = 0; ai < 2; ++ai)
#pragma unroll
                for (int m = 0; m < 4; ++m)
#pragma unroll
                    for (int bj = 0; bj < 2; ++bj)
#pragma unroll
                        for (int n = 0; n < 2; ++n) *(f32x4*)(pb + (size_t)(ai * 128 + m * 16) * D + bj * 128 + 4 * n) = acc[ai][bj][m][n];
            return;
        }
        const int row0 = u.pm * 256 + wr * 64 + fr;
#pragma unroll
        for (int ai = 0; ai < 2; ++ai)
#pragma unroll
            for (int m = 0; m < 4; ++m) {
                const int row = row0 + ai * 128 + m * 16;
                float* dst = row < MREAL ? out_row(R, row) : nullptr;
                if (dst) {
#pragma unroll
                    for (int bj = 0; bj < 2; ++bj)
#pragma unroll
                        for (int n = 0; n < 2; ++n) { f32x4* p = (f32x4*)(dst + c0 + bj * 128 + 4 * n); *p = *p + acc[ai][bj][m][n]; }
                }
            }
    }
};

__device__ __forceinline__ void p0_transpose_item(const float* W, int K, int N, bf16* WT, int k0, int n0, int drow0, LAS float* scr, int lane) {
#pragma unroll 8
    for (int i = 0; i < 32; ++i) { const int kk = 2 * i + (lane >> 5); scr[kk * 33 + (lane & 31)] = W[(size_t)(k0 + kk) * N + n0 + (lane & 31)]; }
    asm volatile("s_waitcnt lgkmcnt(0)" ::: "memory");
    const int c = lane & 7;
#pragma unroll
    for (int j = 0; j < 4; ++j) { const int n = (lane >> 3) + 8 * j; const LAS float* s = scr + (8 * c) * 33 + n;
        v4u o; o.x = pk2(s[0 * 33], s[1 * 33]); o.y = pk2(s[2 * 33], s[3 * 33]); o.z = pk2(s[4 * 33], s[5 * 33]); o.w = pk2(s[6 * 33], s[7 * 33]);
        *(v4u*)(WT + (size_t)(drow0 + n) * K + k0 + 8 * c) = o; }
    asm volatile("s_waitcnt lgkmcnt(0)" ::: "memory");
}
__device__ __forceinline__ int glu_row(int n0) {
    if (n0 < 4096) return n0;
    if (n0 < 5120) { const int c = n0 - 4096; return 4096 + (c >> 7) * 256 + (c & 127); }
    const int c = n0 - 5120; return 4096 + (c >> 7) * 256 + 128 + (c & 127);
}
__device__ __forceinline__ void p0_prologue(const Args& a, LAS unsigned char* lds, int tid, int lane, int wave) {
    unsigned char* ws = a.ws;
    LAS float* scr = (LAS float*)(lds + wave * 16384);
    const int gw = blockIdx.x * 8 + wave, NGW = gridDim.x * 8;
    constexpr int I_IN = (D / 64) * (NIN / 32), I_OUT = (D / 64) * (D / 32), I_G = (D / 64) * (FF / 32), I_DN = (FF / 64) * (D / 32);
    constexpr int NITEMS = I_IN + I_OUT + 2 * I_G + I_DN;
    for (int it = gw; it < NITEMS; it += NGW) {
        int r = it;
        if (r < I_IN) { const int nblk = NIN / 32, kb = r / nblk, nb = r % nblk; p0_transpose_item(a.in[I_WIN], D, NIN, (bf16*)(ws + WS_WIN), 64 * kb, 32 * nb, glu_row(32 * nb), scr, lane); continue; } r -= I_IN;
        if (r < I_OUT) { const int nblk = D / 32, kb = r / nblk, nb = r % nblk; p0_transpose_item(a.in[I_WOUT], D, D, (bf16*)(ws + WS_WOUT), 64 * kb, 32 * nb, 32 * nb, scr, lane); continue; } r -= I_OUT;
        if (r < I_G) { const int nblk = FF / 32, kb = r / nblk, nb = r % nblk, n0 = 32 * nb; p0_transpose_item(a.in[I_WG], D, FF, (bf16*)(ws + WS_WGU), 64 * kb, n0, (n0 >> 7) * 256 + (n0 & 127), scr, lane); continue; } r -= I_G;
        if (r < I_G) { const int nblk = FF / 32, kb = r / nblk, nb = r % nblk, n0 = 32 * nb; p0_transpose_item(a.in[I_WU], D, FF, (bf16*)(ws + WS_WGU), 64 * kb, n0, (n0 >> 7) * 256 + 128 + (n0 & 127), scr, lane); continue; } r -= I_G;
        { const int nblk = D / 32, kb = r / nblk, nb = r % nblk; p0_transpose_item(a.in[I_WD], FF, D, (bf16*)(ws + WS_WD), 64 * kb, 32 * nb, 32 * nb, scr, lane); }
    }
    RowMap R{a.in[I_XP], a.in[I_XS], a.in[I_META], a.out};
    const float* gm = a.in[I_GMIX]; bf16* XN = (bf16*)(ws + WS_XN);
    for (int m = gw; m < MP; m += NGW) {
        v4u* o = (v4u*)(XN + (size_t)m * D) + lane;
        if (m >= MREAL) {
#pragma unroll
            for (int j = 0; j < 4; ++j) o[64 * j] = (v4u){0u, 0u, 0u, 0u};
            continue; }
        const f32x4* xr = (const f32x4*)src_row(R, m);
        f32x4 v[8]; float s = 0.f;
#pragma unroll
        for (int j = 0; j < 4; ++j) { v[2 * j] = xr[2 * lane + 128 * j]; v[2 * j + 1] = xr[2 * lane + 128 * j + 1]; }
#pragma unroll
        for (int j = 0; j < 8; ++j) s += (v[j][0] * v[j][0] + v[j][1] * v[j][1]) + (v[j][2] * v[j][2] + v[j][3] * v[j][3]);
        const float rstd = rsqrtf(wave_sum(s) * (1.f / D) + EPS);
#pragma unroll
        for (int j = 0; j < 4; ++j) { const f32x4 g0 = ((const f32x4*)gm)[2 * lane + 128 * j], g1 = ((const f32x4*)gm)[2 * lane + 128 * j + 1];
            const f32x4 a0 = v[2 * j] * rstd * g0, a1 = v[2 * j + 1] * rstd * g1;
            v4u w; w.x = pk2(a0[0], a0[1]); w.y = pk2(a0[2], a0[3]); w.z = pk2(a1[0], a1[1]); w.w = pk2(a1[2], a1[3]);
            o[64 * j] = w; }
    }
    float* ctl = (float*)(ws + WS_CTL);
    for (int i = blockIdx.x * 512 + tid; i < AW; i += gridDim.x * 512) { const float l0 = a.in[I_LB][i], l1 = a.in[I_LB][AW + i]; const float mx = fmaxf(l0, l1);
        const float e0 = __expf(l0 - mx), e1 = __expf(l1 - mx); ctl[i] = e0 / (e0 + e1); }
    for (int i = blockIdx.x * 512 + tid; i < MP; i += gridDim.x * 512) { ctl[16384 + i] = 0.f; ctl[32768 + i] = 0.f; }
}

constexpr int L_KT2 = 2048, L_TOT = 0, L_QP = 2048, L_QT = 19456, L_KT = 36864, L_VT = 54272, L_ST = 72704, L_PM = 107520, L_OB = 19456;
constexpr int RS_K = 136, RS_S = 72;
__device__ __forceinline__ void chunk_rows(int it, int& rowbase, int& nvalid, int& col0) {
    const int c = it % NCHUNK, bh = it / NCHUNK, h = bh & 7, b = bh >> 3;
    col0 = h * 128;
    if (c == 0) { rowbase = b * TP; nvalid = NMETA; } else { rowbase = b * TP + NMETA + (c - 1) * 64; nvalid = 64; }
}
__device__ __forceinline__ bf16x8 lds_frag(const LAS unsigned char* p) { return *(const LAS bf16x8*)p; }


__device__ __forceinline__ void hl_load(const float* LF, const bf16* V, int it, int c_, int seg, float (&lf)[16], unsigned short (&vr)[16]) {
    int rowbase, nvalid, col0; chunk_rows(it, rowbase, nvalid, col0);
    const size_t base = (size_t)(rowbase + seg * 16) * 1024 + col0 + c_;
#pragma unroll
    for (int i = 0; i < 16; ++i) { lf[i] = LF[base + (size_t)i * 1024]; vr[i] = V[base + (size_t)i * 1024]; }
}
__device__ __forceinline__ void hgrn_local(const Args& a, LAS unsigned char* lds, int tid, int lane, int wave) {
    unsigned char* ws = a.ws;
    const float* LF = (const float*)(ws + WS_LF); const bf16* V = (const bf16*)(ws + WS_V);
    bf16* SB = (bf16*)(ws + WS_SB); float* AC = (float*)(ws + WS_AC);
    LAS float* tot = (LAS float*)(lds + L_TOT);
    const int c_ = tid & 127, seg = tid >> 7, G = gridDim.x;
    float nlf[16]; unsigned short nvr[16];
    int it = blockIdx.x;
    if (it < NITEM) hl_load(LF, V, it, c_, seg, nlf, nvr);
    for (; it < NITEM; it += G) {
        int rowbase, nvalid, col0; chunk_rows(it, rowbase, nvalid, col0);
        float lf[16], pre[16]; unsigned vv[8];
#pragma unroll
        for (int i = 0; i < 16; ++i) lf[i] = (seg * 16 + i) < nvalid ? nlf[i] : 0.f;
#pragma unroll
        for (int i = 0; i < 8; ++i) { const int s = seg * 16 + 2 * i; vv[i] = (s < nvalid ? (unsigned)nvr[2 * i] : 0u) | ((s + 1 < nvalid ? (unsigned)nvr[2 * i + 1] : 0u) << 16); }
        float run = 0.f;
#pragma unroll
        for (int i = 0; i < 16; ++i) { run += lf[i]; pre[i] = run; }
        tot[seg * 128 + c_] = run;
        __syncthreads();
        if (it + G < NITEM) hl_load(LF, V, it + G, c_, seg, nlf, nvr);
        const float t0 = tot[c_], t1 = tot[128 + c_], t2 = tot[256 + c_], t3 = tot[384 + c_];
        const float off = seg == 0 ? 0.f : (seg == 1 ? t0 : (seg == 2 ? t0 + t1 : t0 + t1 + t2)), blast = (t0 + t1) + (t2 + t3);
        unsigned kk[8];
#pragma unroll
        for (int i = 0; i < 8; ++i) {
            const float k0 = (1.f - __expf(lf[2 * i])) * __expf(blast - (off + pre[2 * i])), k1 = (1.f - __expf(lf[2 * i + 1])) * __expf(blast - (off + pre[2 * i + 1]));
            kk[i] = pk2(k0, k1); }
        LAS unsigned char* kt = lds + L_KT2 + c_ * (RS_S * 2) + seg * 32;
        LAS unsigned char* vt = lds + L_VT + c_ * (RS_S * 2) + seg * 32;
        *(LAS v4u*)kt = (v4u){kk[0], kk[1], kk[2], kk[3]}; *(LAS v4u*)(kt + 16) = (v4u){kk[4], kk[5], kk[6], kk[7]};
        *(LAS v4u*)vt = (v4u){vv[0], vv[1], vv[2], vv[3]}; *(LAS v4u*)(vt + 16) = (v4u){vv[4], vv[5], vv[6], vv[7]};
        if (seg == 0) AC[(size_t)it * 128 + c_] = __expf(blast);
        __syncthreads();
        const int r = lane & 15, q = lane >> 4;
        f32x4 acc[8];
#pragma unroll
        for (int n = 0; n < 8; ++n) acc[n] = (f32x4){0.f, 0.f, 0.f, 0.f};
#pragma unroll
        for (int ks = 0; ks < 2; ++ks) {
            const bf16x8 af = lds_frag(lds + L_KT2 + (wave * 16 + r) * (RS_S * 2) + (ks * 32 + q * 8) * 2);
#pragma unroll
            for (int n = 0; n < 8; ++n) { const bf16x8 bfm = lds_frag(lds + L_VT + (n * 16 + r) * (RS_S * 2) + (ks * 32 + q * 8) * 2);
                acc[n] = __builtin_amdgcn_mfma_f32_16x16x32_bf16(af, bfm, acc[n], 0, 0, 0); }
        }
        bf16* bt = SB + (size_t)it * 16384;
#pragma unroll
        for (int n = 0; n < 8; ++n) { v2u w; w.x = pk2(acc[n][0], acc[n][1]); w.y = pk2(acc[n][2], acc[n][3]);
            *(v2u*)(bt + (n * 16 + r) * 128 + wave * 16 + 4 * q) = w; }
        __syncthreads();
    }
}

__device__ __forceinline__ void hgrn_scan(const Args& a, int tid) {
    unsigned char* ws = a.ws; bf16* SB = (bf16*)(ws + WS_SB); const float* AC = (const float*)(ws + WS_AC);
    float* outS = a.out + O_SHP;
    for (int g = blockIdx.x * 512 + tid; g < NB * NH * 128 * 32; g += gridDim.x * 512) {
        const int bh = g >> 12, rem = g & 4095, v = rem >> 5, k4 = rem & 31;
        float S0 = 0.f, S1 = 0.f, S2 = 0.f, S3 = 0.f;
#pragma unroll 11
        for (int c = 0; c < NCHUNK; ++c) {
            const size_t it = (size_t)bh * NCHUNK + c;
            const f32x4 dec = *(const f32x4*)(AC + it * 128 + 4 * k4);
            v2u* p = (v2u*)(SB + it * 16384 + v * 128 + 4 * k4);
            const v2u bw = *p;
            v2u sw; sw.x = pk2(S0, S1); sw.y = pk2(S2, S3); *p = sw;
            S0 = dec[0] * S0 + bflo(bw.x); S1 = dec[1] * S1 + bfhi(bw.x); S2 = dec[2] * S2 + bflo(bw.y); S3 = dec[3] * S3 + bfhi(bw.y);
        }
        float* o = outS + ((size_t)bh * 128 + 4 * k4) * 128 + v;
        o[0] = S0; o[128] = S1; o[256] = S2; o[384] = S3;
    }
}

struct HoPre { float lf[16]; unsigned short vr[16], qr[16]; v4u st[4]; v4u g[2]; f32x4 hg[4]; };
__device__ __forceinline__ void ho_load(const float* LF, const bf16* V, const bf16* Qs, const bf16* G, const bf16* SB, const float* hgp, int it, int tid, HoPre& P) {
    int rowbase, nvalid, col0; chunk_rows(it, rowbase, nvalid, col0);
    const int c_ = tid & 127, seg = tid >> 7;
    const size_t base = (size_t)(rowbase + seg * 16) * 1024 + col0 + c_;
#pragma unroll
    for (int i = 0; i < 16; ++i) { P.lf[i] = LF[base + (size_t)i * 1024]; P.vr[i] = V[base + (size_t)i * 1024]; P.qr[i] = Qs[base + (size_t)i * 1024]; }
    const v4u* sp = (const v4u*)(SB + (size_t)it * 16384);
#pragma unroll
    for (int j = 0; j < 4; ++j) P.st[j] = sp[tid + 512 * j];
    const int t = tid >> 3, v0 = (tid & 7) * 16;
    const v4u* gp = (const v4u*)(G + (size_t)(rowbase + t) * 1024 + col0 + v0); P.g[0] = gp[0]; P.g[1] = gp[1];
    const f32x4* hp = (const f32x4*)(hgp + col0 + v0);
#pragma unroll
    for (int j = 0; j < 4; ++j) P.hg[j] = hp[j];
}
__device__ __forceinline__ void hgrn_out(const Args& a, LAS unsigned char* lds, int tid, int lane, int wave) {
    unsigned char* ws = a.ws;
    const float* LF = (const float*)(ws + WS_LF); const bf16* V = (const bf16*)(ws + WS_V); const bf16* Qs = (const bf16*)(ws + WS_QS); const bf16* G = (const bf16*)(ws + WS_G);
    const bf16* SB = (const bf16*)(ws + WS_SB); bf16* A2 = (bf16*)(ws + WS_A2); const float* hg = a.in[I_HG];
    LAS float* tot = (LAS float*)(lds + L_TOT);
    const int c_ = tid & 127, seg = tid >> 7, Gd = gridDim.x;
    HoPre P;
    int it = blockIdx.x;
    if (it < NITEM) ho_load(LF, V, Qs, G, SB, hg, it, tid, P);
    for (; it < NITEM; it += Gd) {
        int rowbase, nvalid, col0; chunk_rows(it, rowbase, nvalid, col0);
        float lf[16], pre[16], qv[16];
#pragma unroll
        for (int i = 0; i < 16; ++i) { const bool ok = (seg * 16 + i) < nvalid; lf[i] = ok ? P.lf[i] : 0.f; qv[i] = ok ? bf2f(P.qr[i]) : 0.f; }
        float run = 0.f;
#pragma unroll
        for (int i = 0; i < 16; ++i) { run += lf[i]; pre[i] = run; }
        tot[seg * 128 + c_] = run;
        { unsigned vv[8];
#pragma unroll
          for (int i = 0; i < 8; ++i) { const int s = seg * 16 + 2 * i; vv[i] = (s < nvalid ? (unsigned)P.vr[2 * i] : 0u) | ((s + 1 < nvalid ? (unsigned)P.vr[2 * i + 1] : 0u) << 16); }
          LAS unsigned char* vt = lds + L_VT + c_ * (RS_S * 2) + seg * 32;
          *(LAS v4u*)vt = (v4u){vv[0], vv[1], vv[2], vv[3]}; *(LAS v4u*)(vt + 16) = (v4u){vv[4], vv[5], vv[6], vv[7]}; }
#pragma unroll
        for (int j = 0; j < 4; ++j) { const int id = tid + 512 * j, v = id >> 4, kc = id & 15; *(LAS v4u*)(lds + L_ST + v * (RS_K * 2) + kc * 16) = P.st[j]; }
        const v4u gw0 = P.g[0], gw1 = P.g[1]; const f32x4 hg0 = P.hg[0], hg1 = P.hg[1], hg2 = P.hg[2], hg3 = P.hg[3];
        __syncthreads();
        if (it + Gd < NITEM) ho_load(LF, V, Qs, G, SB, hg, it + Gd, tid, P);
        const float t0 = tot[c_], t1 = tot[128 + c_], t2 = tot[256 + c_];
        const float off = seg == 0 ? 0.f : (seg == 1 ? t0 : (seg == 2 ? t0 + t1 : t0 + t1 + t2)), bref = t0 + t1;
#pragma unroll
        for (int i = 0; i < 16; ++i) {
            const int s = seg * 16 + i; const float b = off + pre[i];
            const float qp = qv[i] * __expf(b), qt = qv[i] * __expf(fminf(b - bref, 80.f)), kt = (1.f - __expf(lf[i])) * __expf(fminf(bref - b, 80.f));
            ((LAS bf16*)(lds + L_QP))[s * RS_K + c_] = (bf16)f2bf(qp);
            ((LAS bf16*)(lds + L_QT))[s * RS_K + c_] = (bf16)f2bf(qt);
            ((LAS bf16*)(lds + L_KT))[s * RS_K + c_] = (bf16)f2bf(kt);
        }
        __syncthreads();
        const int r = lane & 15, q = lane >> 4;
        {
            const int sb = wave & 3, tb0 = (wave >> 2) * 2;
            f32x4 sc[2] = {(f32x4){0.f, 0.f, 0.f, 0.f}, (f32x4){0.f, 0.f, 0.f, 0.f}};
#pragma unroll
            for (int ks = 0; ks < 4; ++ks) {
                const bf16x8 af = lds_frag(lds + L_KT + (sb * 16 + r) * (RS_K * 2) + (ks * 32 + q * 8) * 2);
#pragma unroll
                for (int n = 0; n < 2; ++n) { const bf16x8 bfm = lds_frag(lds + L_QT + ((tb0 + n) * 16 + r) * (RS_K * 2) + (ks * 32 + q * 8) * 2);
                    sc[n] = __builtin_amdgcn_mfma_f32_16x16x32_bf16(af, bfm, sc[n], 0, 0, 0); }
            }
#pragma unroll
            for (int n = 0; n < 2; ++n) { const int t = (tb0 + n) * 16 + r, s0 = sb * 16 + 4 * q;
                const float p0 = s0 <= t ? sc[n][0] : 0.f, p1 = s0 + 1 <= t ? sc[n][1] : 0.f, p2 = s0 + 2 <= t ? sc[n][2] : 0.f, p3 = s0 + 3 <= t ? sc[n][3] : 0.f;
                v2u w; w.x = pk2(p0, p1); w.y = pk2(p2, p3);
                *(LAS v2u*)(lds + L_PM + t * (RS_S * 2) + s0 * 2) = w; }
        }
        __syncthreads();
        {
            const int tb = wave & 3, nv0 = (wave >> 2) * 4;
            f32x4 oc[4];
#pragma unroll
            for (int n = 0; n < 4; ++n) oc[n] = (f32x4){0.f, 0.f, 0.f, 0.f};
#pragma unroll
            for (int ks = 0; ks < 2; ++ks) {
                const bf16x8 af = lds_frag(lds + L_PM + (tb * 16 + r) * (RS_S * 2) + (ks * 32 + q * 8) * 2);
#pragma unroll
                for (int n = 0; n < 4; ++n) { const bf16x8 bfm = lds_frag(lds + L_VT + ((nv0 + n) * 16 + r) * (RS_S * 2) + (ks * 32 + q * 8) * 2);
                    oc[n] = __builtin_amdgcn_mfma_f32_16x16x32_bf16(af, bfm, oc[n], 0, 0, 0); }
            }
#pragma unroll
            for (int ks = 0; ks < 4; ++ks) {
                const bf16x8 af = lds_frag(lds + L_QP + (tb * 16 + r) * (RS_K * 2) + (ks * 32 + q * 8) * 2);
#pragma unroll
                for (int n = 0; n < 4; ++n) { const bf16x8 bfm = lds_frag(lds + L_ST + ((nv0 + n) * 16 + r) * (RS_K * 2) + (ks * 32 + q * 8) * 2);
                    oc[n] = __builtin_amdgcn_mfma_f32_16x16x32_bf16(af, bfm, oc[n], 0, 0, 0); }
            }
#pragma unroll
            for (int n = 0; n < 4; ++n)
#pragma unroll
                for (int j = 0; j < 4; ++j) ((LAS float*)(lds + L_OB))[(tb * 16 + 4 * q + j) * 132 + (nv0 + n) * 16 + r] = oc[n][j];
        }
        __syncthreads();
        {
            const int t = tid >> 3, part = tid & 7, v0 = part * 16;
            const LAS f32x4* op = (const LAS f32x4*)(lds + L_OB + (t * 132 + v0) * 4);
            f32x4 o4[4]; float ss = 0.f;
#pragma unroll
            for (int j = 0; j < 4; ++j) { o4[j] = op[j]; ss += (o4[j][0] * o4[j][0] + o4[j][1] * o4[j][1]) + (o4[j][2] * o4[j][2] + o4[j][3] * o4[j][3]); }
            ss += __shfl_xor(ss, 1); ss += __shfl_xor(ss, 2); ss += __shfl_xor(ss, 4);
            const float rstd = rsqrtf(ss * (1.f / 128.f) + EPS);
            if (t < nvalid) {
                v4u* dst = (v4u*)(A2 + (size_t)(rowbase + t) * D + col0 + v0);
                { const f32x4 x0 = o4[0] * rstd * hg0, x1 = o4[1] * rstd * hg1; v4u w;
                  w.x = pk2(x0[0] * bflo(gw0.x), x0[1] * bfhi(gw0.x)); w.y = pk2(x0[2] * bflo(gw0.y), x0[3] * bfhi(gw0.y));
                  w.z = pk2(x1[0] * bflo(gw0.z), x1[1] * bfhi(gw0.z)); w.w = pk2(x1[2] * bflo(gw0.w), x1[3] * bfhi(gw0.w)); dst[0] = w; }
                { const f32x4 x0 = o4[2] * rstd * hg2, x1 = o4[3] * rstd * hg3; v4u w;
                  w.x = pk2(x0[0] * bflo(gw1.x), x0[1] * bfhi(gw1.x)); w.y = pk2(x0[2] * bflo(gw1.y), x0[3] * bfhi(gw1.y));
                  w.z = pk2(x1[0] * bflo(gw1.z), x1[1] * bfhi(gw1.z)); w.w = pk2(x1[2] * bflo(gw1.w), x1[3] * bfhi(gw1.w)); dst[1] = w; }
            }
        }
        __syncthreads();
    }
}

constexpr int L_CT = 0, L_CS = 34816, CT_RS = 260;
__device__ __forceinline__ void cp_load(const bf16* U, int pr, int ch, int half, unsigned short (&ur)[46]) {
    constexpr int NTT = (TP + 31) / 32;
    const int tt = pr % NTT, b = pr / NTT, t0 = tt * 32 + half * 16;
#pragma unroll
    for (int j = 0; j < 46; ++j) { int tok = t0 - 30 + j; tok = tok < 0 ? 0 : (tok > TP - 1 ? TP - 1 : tok); ur[j] = U[(size_t)(b * TP + tok) * 1024 + ch]; }
}
__device__ __forceinline__ void conv_prompt(const Args& a, LAS unsigned char* lds, int tid, int lane, int wave) {
    unsigned char* ws = a.ws; const bf16* U = (const bf16*)(ws + WS_U); bf16* A2 = (bf16*)(ws + WS_A2);
    const float* cw = a.in[I_CWT];
    constexpr int NTT = (TP + 31) / 32, NPR = NB * NTT;
    LAS float* CT = (LAS float*)(lds + L_CT); LAS float* CS = (LAS float*)(lds + L_CS);
    {
        const int cbk = blockIdx.x & 3, cl = tid & 255, ch = cbk * 256 + cl, half = tid >> 8, stride = gridDim.x >> 2;
        float w[CW];
#pragma unroll
        for (int j = 0; j < CW; ++j) w[j] = cw[j * 1024 + ch];
        const float bias = a.in[I_CB][ch], gg = a.in[I_GNG][ch], gb = a.in[I_GNB][ch];
        unsigned short ur[46];
        int pr = blockIdx.x >> 2;
        if (pr < NPR) cp_load(U, pr, ch, half, ur);
        for (; pr < NPR; pr += stride) {
            const int tt = pr % NTT, b = pr / NTT, t0 = tt * 32 + half * 16;
            float uw[46];
#pragma unroll
            for (int j = 0; j < 46; ++j) { const int tok = t0 - 30 + j; uw[j] = (tok >= 0 && tok < TP) ? bf2f(ur[j]) : 0.f; }
            float c[16];
#pragma unroll
            for (int i = 0; i < 16; ++i) { float s = bias;
#pragma unroll
                for (int j = 0; j < CW; ++j) s += w[j] * uw[i + j];
                c[i] = s; CT[(half * 16 + i) * CT_RS + cl] = s; }
            __syncthreads();
            if (pr + stride < NPR) cp_load(U, pr + stride, ch, half, ur);
            {
                const int tok = tid >> 4, sub = tid & 15;
                const LAS f32x4* p = (const LAS f32x4*)(CT + tok * CT_RS + sub * 16);
                float s1 = 0.f, s2 = 0.f;
#pragma unroll
                for (int k = 0; k < 4; ++k) { const f32x4 x = p[k]; s1 += (x[0] + x[1]) + (x[2] + x[3]); s2 += (x[0] * x[0] + x[1] * x[1]) + (x[2] * x[2] + x[3] * x[3]); }
                s1 += __shfl_xor(s1, 1); s2 += __shfl_xor(s2, 1); s1 += __shfl_xor(s1, 2); s2 += __shfl_xor(s2, 2); s1 += __shfl_xor(s1, 4); s2 += __shfl_xor(s2, 4);
                if ((tid & 7) == 0) { const float mu = s1 * (1.f / 128.f), var = fmaxf(s2 * (1.f / 128.f) - mu * mu, 0.f);
                    CS[(tok * 2 + (sub >> 3)) * 2] = mu; CS[(tok * 2 + (sub >> 3)) * 2 + 1] = rsqrtf(var + EPS); }
            }
            __syncthreads();
            const int grp = cl >> 7;
#pragma unroll
            for (int i = 0; i < 16; ++i) {
                const int tl = half * 16 + i; const float mu = CS[(tl * 2 + grp) * 2], rs = CS[(tl * 2 + grp) * 2 + 1];
                const float cn = (c[i] - mu) * rs * gg + gb;
                const int tok = t0 + i;
                if (tok < TP) A2[(size_t)(b * TP + tok) * D + 1024 + ch] = (bf16)f2bf(siluf_(cn));
            }
        }
    }
    float* o = a.out + O_SCP;
    for (int i = blockIdx.x * 512 + tid; i < NB * 30 * 1024; i += gridDim.x * 512) { const int ch = i & 1023, j = (i >> 10) % 30, b = (i >> 10) / 30;
        o[i] = bf2f(U[(size_t)(b * TP + TP - 30 + j) * 1024 + ch]); }
}
__device__ __forceinline__ void conv_sample_wave(const Args& a, int item, int lane) {
    unsigned char* ws = a.ws; const bf16* U = (const bf16*)(ws + WS_U); bf16* A2 = (bf16*)(ws + WS_A2);
    typedef float f32x2 __attribute__((ext_vector_type(2)));
    const int sb = item >> 3, ch = (item & 7) * 128 + 2 * lane;
    const float* cw = a.in[I_CWT] + ch; const float* st = a.in[I_SC] + (size_t)sb * 30 * 1024 + ch; float* ot = a.out + O_SCS + (size_t)sb * 30 * 1024 + ch;
    const unsigned uw = *(const unsigned*)(U + (size_t)(MPROMPT + sb) * 1024 + ch);
    f32x2 x[30];
#pragma unroll
    for (int j = 0; j < 30; ++j) x[j] = *(const f32x2*)(st + j * 1024);
    f32x2 s = *(const f32x2*)(a.in[I_CB] + ch);
#pragma unroll
    for (int j = 0; j < 30; ++j) { s += *(const f32x2*)(cw + j * 1024) * x[j]; if (j >= 1) *(f32x2*)(ot + (j - 1) * 1024) = x[j]; }
    const f32x2 un = (f32x2){bflo(uw), bfhi(uw)};
    s += *(const f32x2*)(cw + 30 * 1024) * un; *(f32x2*)(ot + 29 * 1024) = un;
    const float s1 = wave_sum(s[0] + s[1]), s2 = wave_sum(s[0] * s[0] + s[1] * s[1]);
    const float mu = s1 * (1.f / 128.f), rs = rsqrtf(fmaxf(s2 * (1.f / 128.f) - mu * mu, 0.f) + EPS);
    const f32x2 gg = *(const f32x2*)(a.in[I_GNG] + ch), gb = *(const f32x2*)(a.in[I_GNB] + ch);
    const float c0 = (s[0] - mu) * rs * gg[0] + gb[0], c1 = (s[1] - mu) * rs * gg[1] + gb[1];
    *(unsigned*)(A2 + (size_t)(MPROMPT + sb) * D + 1024 + ch) = pk2(siluf_(c0), siluf_(c1));
}
__device__ __forceinline__ void hgrn_sample_wave(const Args& a, int item, int lane) {
    unsigned char* ws = a.ws;
    typedef float f32x2 __attribute__((ext_vector_type(2)));
    const float* LF = (const float*)(ws + WS_LF); const bf16* V = (const bf16*)(ws + WS_V); const bf16* Qs = (const bf16*)(ws + WS_QS); const bf16* G = (const bf16*)(ws + WS_G);
    bf16* A2 = (bf16*)(ws + WS_A2);
    const int sb = item >> 3, h = item & 7; const size_t rb = (size_t)(MPROMPT + sb) * 1024 + h * 128;
    const float* sp = a.in[I_SH] + (size_t)item * 16384 + 2 * lane; float* so = a.out + O_SHS + (size_t)item * 16384 + 2 * lane;
    float qa[2], fa[2], ka[2];
#pragma unroll
    for (int hh = 0; hh < 2; ++hh) { const float f = __expf(LF[rb + hh * 64 + lane]); qa[hh] = bf2f(Qs[rb + hh * 64 + lane]); fa[hh] = f; ka[hh] = 1.f - f; }
    const unsigned vw = *(const unsigned*)(V + rb + 2 * lane);
    const f32x2 vv = (f32x2){bflo(vw), bfhi(vw)};
    f32x2 o = (f32x2){0.f, 0.f};
#pragma unroll
    for (int hh = 0; hh < 2; ++hh) {
#pragma unroll 16
        for (int k = 0; k < 64; ++k) {
            const float qk = __builtin_bit_cast(float, __builtin_amdgcn_readlane(__builtin_bit_cast(int, qa[hh]), k));
            const float fk = __builtin_bit_cast(float, __builtin_amdgcn_readlane(__builtin_bit_cast(int, fa[hh]), k));
            const float kk = __builtin_bit_cast(float, __builtin_amdgcn_readlane(__builtin_bit_cast(int, ka[hh]), k));
            const f32x2 s = *(const f32x2*)(sp + (hh * 64 + k) * 128);
            const f32x2 sn = s * fk + vv * kk;
            *(f32x2*)(so + (hh * 64 + k) * 128) = sn;
            o += sn * qk;
        }
    }
    const float ss = wave_sum(o[0] * o[0] + o[1] * o[1]);
    const float rstd = rsqrtf(ss * (1.f / 128.f) + EPS);
    const unsigned gw = *(const unsigned*)(G + rb + 2 * lane);
    const f32x2 hgv = *(const f32x2*)(a.in[I_HG] + h * 128 + 2 * lane);
    *(unsigned*)(A2 + (size_t)(MPROMPT + sb) * D + h * 128 + 2 * lane) = pk2(o[0] * rstd * hgv[0] * bflo(gw), o[1] * rstd * hgv[1] * bfhi(gw));
}
__device__ __forceinline__ void sample_stage(const Args& a, int lane, int wave) {
    const int nw = gridDim.x * 4;
    if (wave < 4) { for (int it = blockIdx.x * 4 + wave; it < NS * NH; it += nw) hgrn_sample_wave(a, it, lane); }
    else          { for (int it = blockIdx.x * 4 + (wave - 4); it < NS * 8; it += nw) conv_sample_wave(a, it, lane); }
}

__device__ __forceinline__ void final_norm(const Args& a, int lane, int wave) {
    RowMap R{a.in[I_XP], a.in[I_XS], a.in[I_META], a.out};
    const f32x4* g = (const f32x4*)a.in[I_GFIN]; const float* part = (const float*)(a.ws + WS_PART);
    for (int m = blockIdx.x * 8 + wave; m < MREAL; m += gridDim.x * 8) {
        float* dst = out_row(R, m); if (!dst) continue;
        f32x4* p = (f32x4*)dst + lane;
        f32x4 v[8];
#pragma unroll
        for (int j = 0; j < 8; ++j) v[j] = p[64 * j];
        if (m >= MAIN_ROWS) {
            for (int s = 0; s < NSLICE; ++s) { const f32x4* q = (const f32x4*)(part + ((size_t)s * 256 + (m - MAIN_ROWS)) * D) + lane;
#pragma unroll
                for (int j = 0; j < 8; ++j) v[j] += q[64 * j]; }
        }
        float ss = 0.f;
#pragma unroll
        for (int j = 0; j < 8; ++j) ss += (v[j][0] * v[j][0] + v[j][1] * v[j][1]) + (v[j][2] * v[j][2] + v[j][3] * v[j][3]);
        const float rstd = rsqrtf(wave_sum(ss) * (1.f / D) + EPS);
#pragma unroll
        for (int j = 0; j < 8; ++j) p[64 * j] = v[j] * rstd * g[lane + 64 * j];
    }
}

#define XB_TMO      128
#define XB_XCNT(j)  (256  + 64 * (j))
#define XB_XSUB(j)  (1280 + 64 * (j))
#define XB_XGEN(j)  (2304 + 64 * (j))
#define XB_TOP      3328
#define XB_TOPGEN   3392
#define XCD_BAR_WORDS 3456
#define XB_SPIN_CAP (1u << 18)

__device__ __forceinline__ unsigned xb_ld(unsigned* p)              { return __hip_atomic_load(p, __ATOMIC_RELAXED, __HIP_MEMORY_SCOPE_AGENT); }
__device__ __forceinline__ unsigned xb_add(unsigned* p, unsigned v) { return __hip_atomic_fetch_add(p, v, __ATOMIC_RELAXED, __HIP_MEMORY_SCOPE_AGENT); }
__device__ __forceinline__ unsigned xb_xcc_id() { return (unsigned)__builtin_amdgcn_s_getreg((3 << 11) | 20) & 0xFu; }
#define XB_SPIN(cond, bar) do { unsigned _sp = 0; while (cond) { __builtin_amdgcn_s_sleep(1); \
    if ((++_sp & 255u) == 0u) { if (xb_ld(&(bar)[XB_TMO])) break; if (_sp > XB_SPIN_CAP) { atomicAdd(&(bar)[XB_TMO], 1u); break; } } } } while (0)

struct XcdBarrier {
    unsigned* bar; unsigned x;
    volatile LAS unsigned* st;
};

__device__ __forceinline__ XcdBarrier xcd_barrier_post(unsigned* bar, volatile LAS unsigned* st) {
    XcdBarrier b; b.bar = bar; b.x = xb_xcc_id(); b.st = st;
    if (threadIdx.x == 0) (void)xb_add(&bar[XB_XCNT(b.x)], 1u);
    return b;
}
__device__ __forceinline__ void xcd_barrier_complete(unsigned* bar, unsigned x, unsigned& nloc, unsigned& nx) {
    const unsigned G = gridDim.x * gridDim.y * gridDim.z;
    unsigned sum, cnt, mine, sp = 0u;
    for (;;) {
        sum = 0u; cnt = 0u; mine = 0u;
#pragma unroll
        for (unsigned j = 0; j < 16; ++j) { const unsigned c = xb_ld(&bar[XB_XCNT(j)]); sum += c; cnt += (c > 0u) ? 1u : 0u; mine = (j == x) ? c : mine; }
        if (sum == G) break;
        __builtin_amdgcn_s_sleep(1);
        if ((++sp & 255u) == 0u) { if (xb_ld(&bar[XB_TMO])) break; if (sp > XB_SPIN_CAP) { atomicAdd(&bar[XB_TMO], 1u); break; } }
    }
    nloc = mine > 0u ? mine : 1u; nx = cnt > 0u ? cnt : 1u;
}

__device__ __forceinline__ void xcd_barrier(const XcdBarrier& b) {
    asm volatile("s_waitcnt vmcnt(0)" ::: "memory");
    __syncthreads();
    if (threadIdx.x == 0) {
        unsigned* bar = b.bar;
        __builtin_amdgcn_s_waitcnt(0);
        unsigned nloc = b.st[0], nx = b.st[1];
        if (nloc == 0u) { xcd_barrier_complete(bar, b.x, nloc, nx); b.st[0] = nloc; b.st[1] = nx; }
        const unsigned old = xb_add(&bar[XB_XSUB(b.x)], 1u);
        const unsigned gen = old / nloc;
        if (old + 1u == (gen + 1u) * nloc) {
            __builtin_amdgcn_fence(__ATOMIC_RELEASE, "agent");
            asm volatile("s_waitcnt vmcnt(0)" ::: "memory");
            const unsigned og = xb_add(&bar[XB_TOP], 1u);
            const unsigned tg = og / nx;
            if (og + 1u == (tg + 1u) * nx) xb_add(&bar[XB_TOPGEN], 1u);
            else XB_SPIN(xb_ld(&bar[XB_TOPGEN]) == tg, bar);
            __builtin_amdgcn_fence(__ATOMIC_ACQUIRE, "agent");
            xb_add(&bar[XB_XGEN(b.x)], 1u);
            asm volatile("s_waitcnt vmcnt(0)" ::: "memory");
        } else {
            XB_SPIN(xb_ld(&bar[XB_XGEN(b.x)]) == gen, bar);
            __builtin_amdgcn_fence(__ATOMIC_ACQUIRE, "agent");
            asm volatile("s_waitcnt vmcnt(0)" ::: "memory");
        }
    }
    __syncthreads();
}

constexpr int NPHASE = 9;
#ifndef REP_P0
#define REP_P0 1
#endif
#ifndef REP_G1
#define REP_G1 1
#endif
#ifndef REP_P2
#define REP_P2 1
#endif
#ifndef REP_SYNC
#define REP_SYNC 1
#endif
__global__ void __launch_bounds__(512, 2) hymba_fwd(Args args) {
    extern __shared__ __attribute__((aligned(16))) unsigned char lds_raw[];
    LAS unsigned char* lds = (LAS unsigned char*)lds_raw;
    cg::grid_group grid = cg::this_grid();
    const int tid = threadIdx.x, lane = tid & 63, wave = __builtin_amdgcn_readfirstlane(tid >> 6);
    unsigned char* ws = args.ws;
    const int lo = args.ph_lo, hi = args.ph_hi;
#define IN(k) (lo <= (k) && (k) < hi)
#define SEAM(k) do { if (IN(k) && IN((k) + 1)) { for (int rep_ = 0; rep_ < REP_SYNC; ++rep_) xcd_barrier(bar); } } while (0)
    RowMap R{args.in[I_XP], args.in[I_XS], args.in[I_META], args.out};
    if (lo < 0) grid.sync();
    if (tid < 64) ((LAS unsigned*)(lds + LDS_MISC))[tid] = 0u;
    __syncthreads();
    XcdBarrier bar; bar.bar = (unsigned*)(ws + WS_BAR); bar.x = 0; bar.st = nullptr;
    if (hi - lo > 1) bar = xcd_barrier_post((unsigned*)(ws + WS_BAR), (volatile LAS unsigned*)(lds + LDS_MISC) + 8);
    if (IN(0)) { for (int rep = 0; rep < REP_P0; ++rep) p0_prologue(args, lds, tid, lane, wave); }
    SEAM(0);
    if (IN(1)) for (int rep = 0; rep < REP_G1; ++rep) {
        pg8::Gemm g{(const bf16*)(ws + WS_XN), (const bf16*)(ws + WS_WIN), MP, NIN, D}; pg8::StaticOrder S; S.init(MP, NIN, gridDim.x, (int)blockIdx.x, D);
        EpiIn E{(bf16*)(ws + WS_QS), (float*)(ws + WS_LF), (bf16*)(ws + WS_V), (bf16*)(ws + WS_G), (bf16*)(ws + WS_U), (const float*)(ws + WS_CTL)};
        pg8::gemm_phase<EpiIn, pg8::StaticOrder, true, true>(lds, g, S, E);
    }
    SEAM(1);
    if (IN(2)) for (int rep = 0; rep < REP_P2; ++rep) { hgrn_local(args, lds, tid, lane, wave); conv_prompt(args, lds, tid, lane, wave); sample_stage(args, lane, wave); }
    SEAM(2);
    if (IN(3)) { hgrn_scan(args, tid); }
    SEAM(3);
    if (IN(4)) for (int rep = 0; rep < REP_P2; ++rep) { hgrn_out(args, lds, tid, lane, wave); }
    SEAM(4);
    if (IN(5)) {
        pg8::Gemm g{(const bf16*)(ws + WS_A2), (const bf16*)(ws + WS_WOUT), MP, D, D}; pg8::StaticOrder S; S.init(MP, D, gridDim.x, (int)blockIdx.x, D);
        EpiOut E{R, (bf16*)(ws + WS_XN), args.in[I_GFFN], (float*)(ws + WS_CTL) + 16384};
        pg8::gemm_phase<EpiOut, pg8::StaticOrder, true, true>(lds, g, S, E);
    }
    SEAM(5);
    if (IN(6)) {
        pg8::Gemm g{(const bf16*)(ws + WS_XN), (const bf16*)(ws + WS_WGU), MP, 2 * FF, D}; pg8::StaticOrder S; S.init(MP, 2 * FF, gridDim.x, (int)blockIdx.x, D);
        EpiGU E{(const float*)(ws + WS_CTL) + 16384, (bf16*)(ws + WS_A4)};
        pg8::gemm_phase<EpiGU, pg8::StaticOrder, true, true>(lds, g, S, E);
    }
    SEAM(6);
    if (IN(7)) {
        pg8::Gemm g{(const bf16*)(ws + WS_A4), (const bf16*)(ws + WS_WD), MP, D, FF}; SplitOrder S; S.init(MAIN_ROWS, D, gridDim.x, (int)blockIdx.x, FF);
        EpiDown E{R, (float*)(ws + WS_PART)};
        pg8::gemm_phase<EpiDown, SplitOrder, true, true>(lds, g, S, E);
    }
    SEAM(7);
    if (IN(8)) { final_norm(args, lane, wave); }
#undef IN
#undef SEAM
}

#ifndef MK_N_LAUNCHES
#define MK_N_LAUNCHES 1
#endif
extern "C" void kernel_launch(void* const* d_in, const int* in_sizes, int n_in, void* d_out, int out_size, void* d_ws, size_t ws_size, hipStream_t stream) {
    static int grid = 0;
    if (grid == 0) {
        if (n_in != 19 || (size_t)out_size != O_END || ws_size < WS_END) { fprintf(stderr, "kernel_launch: unexpected shapes: n_in %d out %d ws %zu (need %zu)\n", n_in, out_size, ws_size, (size_t)WS_END); grid = -1; return; }
        int dev = 0, cus = 0, per_cu = 0;
        if (hipGetDevice(&dev) != hipSuccess || hipDeviceGetAttribute(&cus, hipDeviceAttributeMultiprocessorCount, dev) != hipSuccess) { grid = -1; return; }
        if (hipFuncSetAttribute((const void*)hymba_fwd, hipFuncAttributeMaxDynamicSharedMemorySize, LDS_BYTES) != hipSuccess) { fprintf(stderr, "kernel_launch: hipFuncSetAttribute failed\n"); grid = -1; return; }
        if (hipOccupancyMaxActiveBlocksPerMultiprocessor(&per_cu, (const void*)hymba_fwd, 512, LDS_BYTES) != hipSuccess || per_cu < 1) { fprintf(stderr, "kernel_launch: occupancy query failed (%d)\n", per_cu); (void)hipGetLastError(); grid = -1; return; }
        grid = cus * per_cu;
        if (grid % 4 != 0) { fprintf(stderr, "kernel_launch: grid %d is not a multiple of 4\n", grid); grid = -1; return; }
        fprintf(stderr, "kernel_launch: grid %d (%d CUs x %d)\n", grid, cus, per_cu);
    }
    if (grid < 0) return;
    if (hipMemsetAsync((char*)d_ws + WS_BAR, 0, BAR_BYTES, stream) != hipSuccess) { fprintf(stderr, "kernel_launch: memset failed\n"); return; }
    Args a{};
    for (int i = 0; i < 19; ++i) a.in[i] = (const float*)d_in[i];
    a.out = (float*)d_out; a.ws = (unsigned char*)d_ws;
#if MK_N_LAUNCHES == 1
    a.ph_lo = 0; a.ph_hi = NPHASE;
    void* kargs[] = {&a};
    hipError_t e = hipLaunchCooperativeKernel((const void*)hymba_fwd, dim3(grid), dim3(512), kargs, LDS_BYTES, stream);
    if (e != hipSuccess) fprintf(stderr, "kernel_launch: cooperative launch failed: %s (grid %d)\n", hipGetErrorString(e), grid);
#else
    for (int p = 0; p < NPHASE; ++p) { a.ph_lo = p; a.ph_hi = p + 1; hipLaunchKernelGGL(hymba_fwd, dim3(grid), dim3(512), LDS_BYTES, stream, a); }
#endif
}
```

```cpp
#include <hip/hip_runtime.h>
#include <hip/hip_cooperative_groups.h>
#include <cstdio>
#include <cstdint>
namespace cg = cooperative_groups;
namespace pg8 {
#define PG8_LAS __attribute__((address_space(3)))
typedef unsigned short bf16_t;
typedef short bf16x8 __attribute__((ext_vector_type(8)));
typedef float f32x4 __attribute__((ext_vector_type(4)));
typedef unsigned u32x4 __attribute__((ext_vector_type(4)));
constexpr int BM = 256, BK = 64, HALF = 128, HTB = HALF * BK * 2  , STAGE_BYTES = 8 * HTB, NXCD = 8, WGM = 8;

__host__ __device__ __forceinline__ int lds_byte(int r, int c) { const int st = (r >> 4) * 2 + (c >> 5), rr = r & 15, cc = c & 31, ob = rr * 64 + cc * 2; return st * 1024 + (ob ^ (((ob >> 9) & 1) << 5)); }
__host__ __device__ __forceinline__ void stage_rc(int b, int& R, int& C) { const int st = b / 1024, sb = b % 1024, swz = sb ^ (((sb >> 9) & 1) << 5); R = (st >> 1) * 16 + swz / 64; C = (st & 1) * 32 + (swz % 64) / 2; }
__host__ __device__ __forceinline__ int perm32(int rho) { const int n = rho >> 4, i = rho & 15; return 8 * (i >> 2) + 4 * n + (i & 3); }

struct Unit { int pm, pn, k0, nt; };
struct Gemm { const bf16_t* A; const bf16_t* Bt; int M, N, K; };

struct StaticOrder {
    int nM, nN, nwg, G, c, ntf;
    __host__ __device__ void init(int M, int N, int G_, int c_, int K_) { nM = M / BM; nN = N / BM; nwg = nM * nN; G = G_; c = c_; ntf = K_ / BK; }
    __host__ __device__ bool next(int i, Unit& u) const {
        const long L = (long)i * G + c; if (L >= nwg) return false;
        int wgid = (int)L; { const int q = nwg / NXCD, r = nwg % NXCD, xcd = wgid % NXCD, off = wgid / NXCD; wgid = (xcd < r ? xcd * (q + 1) : r * (q + 1) + (xcd - r) * q) + off; }
        const int nig = WGM * nN, gid = wgid / nig, fm = gid * WGM, gsz = (nM - fm) < WGM ? (nM - fm) : WGM;
        u.pm = fm + ((wgid % nig) % gsz); u.pn = (wgid % nig) / gsz; u.k0 = 0; u.nt = ntf; return true;
    }
    __device__ __forceinline__ void a_ready(const Unit&) const {}
    __device__ __forceinline__ void done(const Unit&) const {}
};
__device__ __forceinline__ unsigned cvt_pk_bf16(float lo, float hi) { unsigned r; asm volatile("v_cvt_pk_bf16_f32 %0, %1, %2" : "=v"(r) : "v"(lo), "v"(hi)); return r; }
template <class Epi, class Sched, bool ALIGN_EPI = false, bool SP2 = false>
__device__ __forceinline__ void gemm_phase(PG8_LAS unsigned char* lds, const Gemm g, const Sched& S, const Epi& E) {
    const int tid = threadIdx.x, wid = __builtin_amdgcn_readfirstlane(tid >> 6), lane = tid & 63, wr = wid >> 2, wc = wid & 3, fr = lane & 15, fq = lane >> 4;
    const int K = g.K;
    unsigned voffA[2], voffB[2];
#pragma unroll
    for (int i = 0; i < 2; ++i) { int R, C; stage_rc(tid * 16 + i * 8192, R, C); const int Rb = Epi::PERM ? ((R & ~31) + perm32(R & 31)) : R;
        voffA[i] = (unsigned)(R * K + C) * 2u; voffB[i] = (unsigned)(Rb * K + C) * 2u; }
    const size_t kstep = (size_t)(BK * 2);
    const size_t hstep = (size_t)HALF * K * 2;
    const size_t tstep = 2 * hstep;
    const unsigned ldsw = (unsigned)wid * 1024u;
    const int aoff = lds_byte(wr * 64 + fr, fq * 8), boff = lds_byte(wc * 32 + fr, fq * 8);
#define PG8_SA(b, h) (((b) * 2 + (h)) * HTB)
#define PG8_SB(b, h) ((4 + (b) * 2 + (h)) * HTB)
#define PG8_STAGE(bufoff, gbase, voff) do { _Pragma("unroll") for (int _i = 0; _i < 2; ++_i) \
        __builtin_amdgcn_global_load_lds((const unsigned*)((const char*)(gbase) + (voff)[_i]), (PG8_LAS unsigned*)(lds + (bufoff) + ldsw + _i * 8192), 16, 0, 0); } while (0)
#define PG8_LDA(dst, b, h) do { _Pragma("unroll") for (int m = 0; m < 4; ++m) _Pragma("unroll") for (int k = 0; k < 2; ++k) dst[m][k] = *(const PG8_LAS bf16x8*)(lds + PG8_SA(b, h) + aoff + m * 2048 + k * 1024); } while (0)
#define PG8_LDB(dst, b, h) do { _Pragma("unroll") for (int n = 0; n < 2; ++n) _Pragma("unroll") for (int k = 0; k < 2; ++k) dst[n][k] = *(const PG8_LAS bf16x8*)(lds + PG8_SB(b, h) + boff + n * 2048 + k * 1024); } while (0)
#define PG8_MMA(ai, bj, At, Bt) do { __builtin_amdgcn_s_setprio(1); _Pragma("unroll") for (int m = 0; m < 4; ++m) _Pragma("unroll") for (int n = 0; n < 2; ++n) _Pragma("unroll") for (int k = 0; k < 2; ++k) \
        acc[ai][bj][m][n] = __builtin_amdgcn_mfma_f32_16x16x32_bf16(Bt[n][k], At[m][k], acc[ai][bj][m][n], 0, 0, 0); __builtin_amdgcn_s_setprio(0); } while (0)
#define PG8_WAIT_V(n) asm volatile("s_waitcnt vmcnt(" #n ")" ::: "memory")
#define PG8_WAIT_L(n) asm volatile("s_waitcnt lgkmcnt(" #n ")" ::: "memory")
#define PG8_BAR __builtin_amdgcn_s_barrier()
#define PG8_SCHED __builtin_amdgcn_sched_barrier(0)
    Unit cur, nxt; int ui = 0;
    if (!S.next(0, cur)) return;
    f32x4 acc[2][2][4][2];
#pragma unroll
    for (int a = 0; a < 2; ++a)
#pragma unroll
        for (int b = 0; b < 2; ++b)
#pragma unroll
            for (int m = 0; m < 4; ++m)
#pragma unroll
                for (int n = 0; n < 2; ++n) acc[a][b][m][n] = (f32x4){0.f, 0.f, 0.f, 0.f};
    bf16x8 At[4][2], B0[2][2], B1[2][2];
    const char* cA = (const char*)g.A + (size_t)cur.pm * tstep + (size_t)cur.k0 * 2; const char* cB = (const char*)g.Bt + (size_t)cur.pn * tstep + (size_t)cur.k0 * 2;
    S.a_ready(cur);
    if constexpr (SP2) {
        PG8_STAGE(PG8_SB(0, 0), cB, voffB); PG8_STAGE(PG8_SB(0, 1), cB + hstep, voffB); PG8_STAGE(PG8_SA(0, 0), cA, voffA); PG8_STAGE(PG8_SA(0, 1), cA + hstep, voffA);
        if (wr == 1) PG8_BAR;
        PG8_WAIT_V(2); PG8_BAR;
        PG8_STAGE(PG8_SB(1, 0), cB + kstep, voffB); PG8_STAGE(PG8_SA(1, 0), cA + kstep, voffA); PG8_STAGE(PG8_SB(1, 1), cB + hstep + kstep, voffB);
        PG8_WAIT_V(6); PG8_BAR;
    } else {
        PG8_STAGE(PG8_SB(0, 0), cB, voffB); PG8_STAGE(PG8_SA(0, 0), cA, voffA); PG8_STAGE(PG8_SB(0, 1), cB + hstep, voffB); PG8_STAGE(PG8_SA(0, 1), cA + hstep, voffA);
        if (wr == 1) PG8_BAR;
        PG8_WAIT_V(4); PG8_BAR;
        PG8_STAGE(PG8_SB(1, 0), cB + kstep, voffB); PG8_STAGE(PG8_SA(1, 0), cA + kstep, voffA); PG8_STAGE(PG8_SB(1, 1), cB + hstep + kstep, voffB);
        PG8_WAIT_V(6); PG8_BAR;
    }
    for (;;) {
        const bool has_next = S.next(ui + 1, nxt);
        const char* nA = has_next ? (const char*)g.A + (size_t)nxt.pm * tstep + (size_t)nxt.k0 * 2 : cA; const char* nB = has_next ? (const char*)g.Bt + (size_t)nxt.pn * tstep + (size_t)nxt.k0 * 2 : cB;
        const int nt = cur.nt;
        for (int t = 0; t < nt; t += 2) {
            const bool last = (t == nt - 2);
            const char* a1 = cA + (size_t)(t + 1) * kstep;
            const char* a2 = last ? nA : cA + (size_t)(t + 2) * kstep; const char* b2 = last ? nB : cB + (size_t)(t + 2) * kstep;
            const char* a3 = a2 + kstep; const char* b3 = b2 + kstep;
            if (last && has_next) S.a_ready(nxt);
            if constexpr (SP2) {
            PG8_LDB(B0, 0, 0); PG8_LDB(B1, 0, 1); PG8_SCHED; PG8_LDA(At, 0, 0); PG8_STAGE(PG8_SA(1, 1), a1 + hstep, voffA);
            PG8_WAIT_V(8); PG8_WAIT_L(0); PG8_BAR; PG8_MMA(0, 0, At, B0); PG8_MMA(0, 1, At, B1); PG8_BAR; PG8_SCHED;
            PG8_LDA(At, 0, 1); PG8_STAGE(PG8_SB(0, 0), b2, voffB); PG8_STAGE(PG8_SB(0, 1), b2 + hstep, voffB); PG8_STAGE(PG8_SA(0, 0), a2, voffA);
            PG8_WAIT_V(8); PG8_WAIT_L(0); PG8_BAR; PG8_MMA(1, 0, At, B0); PG8_MMA(1, 1, At, B1); PG8_BAR; PG8_SCHED;
            PG8_LDB(B0, 1, 0); PG8_LDB(B1, 1, 1); PG8_SCHED; PG8_LDA(At, 1, 0); PG8_STAGE(PG8_SA(0, 1), a2 + hstep, voffA);
            PG8_WAIT_V(8); PG8_WAIT_L(0); PG8_BAR; PG8_MMA(0, 0, At, B0); PG8_MMA(0, 1, At, B1); PG8_BAR; PG8_SCHED;
            PG8_LDA(At, 1, 1); PG8_STAGE(PG8_SB(1, 0), b3, voffB); PG8_STAGE(PG8_SB(1, 1), b3 + hstep, voffB); PG8_STAGE(PG8_SA(1, 0), a3, voffA);
            PG8_WAIT_V(8); PG8_WAIT_L(0); PG8_BAR; PG8_MMA(1, 0, At, B0); PG8_MMA(1, 1, At, B1); PG8_BAR; PG8_SCHED;
            } else {
            PG8_LDB(B0, 0, 0); PG8_SCHED; PG8_LDA(At, 0, 0); PG8_STAGE(PG8_SA(1, 1), a1 + hstep, voffA);
            PG8_WAIT_L(8); PG8_BAR; PG8_WAIT_L(0); PG8_MMA(0, 0, At, B0); PG8_BAR; PG8_SCHED;
            PG8_LDB(B1, 0, 1); PG8_STAGE(PG8_SB(0, 0), b2, voffB);
            PG8_BAR; PG8_WAIT_L(0); PG8_MMA(0, 1, At, B1); PG8_BAR;
            PG8_LDA(At, 0, 1); PG8_STAGE(PG8_SA(0, 0), a2, voffA);
            PG8_BAR; PG8_WAIT_L(0); PG8_MMA(1, 0, At, B0); PG8_BAR; PG8_SCHED;
            PG8_STAGE(PG8_SB(0, 1), b2 + hstep, voffB);
            PG8_WAIT_V(6); PG8_BAR; PG8_MMA(1, 1, At, B1); PG8_BAR;
            PG8_LDB(B0, 1, 0); PG8_SCHED; PG8_LDA(At, 1, 0); PG8_STAGE(PG8_SA(0, 1), a2 + hstep, voffA);
            PG8_WAIT_L(8); PG8_BAR; PG8_WAIT_L(0); PG8_MMA(0, 0, At, B0); PG8_BAR; PG8_SCHED;
            PG8_LDB(B1, 1, 1); PG8_STAGE(PG8_SB(1, 0), b3, voffB);
            PG8_BAR; PG8_WAIT_L(0); PG8_MMA(0, 1, At, B1); PG8_BAR;
            PG8_LDA(At, 1, 1); PG8_STAGE(PG8_SA(1, 0), a3, voffA);
            PG8_BAR; PG8_WAIT_L(0); PG8_MMA(1, 0, At, B0); PG8_BAR; PG8_SCHED;
            PG8_STAGE(PG8_SB(1, 1), b3 + hstep, voffB);
            PG8_WAIT_V(6); PG8_BAR; PG8_MMA(1, 1, At, B1); PG8_BAR;
            }
        }
        if constexpr (ALIGN_EPI) { if (wr == 0) PG8_BAR; }
        if constexpr (!Epi::AFTER_DRAIN) { E(acc, cur, wr, wc, fr, fq); S.done(cur); }
        if (!has_next) break;
#pragma unroll
        for (int a = 0; a < 2; ++a)
#pragma unroll
            for (int b = 0; b < 2; ++b)
#pragma unroll
                for (int m = 0; m < 4; ++m)
#pragma unroll
                    for (int n = 0; n < 2; ++n) acc[a][b][m][n] = (f32x4){0.f, 0.f, 0.f, 0.f};
        cur = nxt; cA = nA; cB = nB; ++ui;
        if constexpr (ALIGN_EPI) { if (wr == 1) PG8_BAR; }
    }
    PG8_WAIT_V(0);
    if constexpr (!ALIGN_EPI) { if (wr == 0) PG8_BAR; }
    PG8_BAR;
    if constexpr (Epi::AFTER_DRAIN) { E.fused(acc, cur, wr, wc, fr, fq, lds, wid, lane); S.done(cur); }
#undef PG8_SA
#undef PG8_SB
#undef PG8_STAGE
#undef PG8_LDA
#undef PG8_LDB
#undef PG8_MMA
#undef PG8_WAIT_V
#undef PG8_WAIT_L
#undef PG8_BAR
#undef PG8_SCHED
}
}

constexpr int D = 2048, NB = 4, SEQ = 2048, NMETA = 16, TP = SEQ + NMETA, MPROMPT = NB * TP, NS = 128, MREAL = MPROMPT + NS, MP = 8448;
constexpr int AW = 1024, NH = 8, NCHUNK = 33, CW = 31, FF = 5632, NIN = 6144, NITEM = NB * NH * NCHUNK;
constexpr float EPS = 1e-6f;
static_assert(MP % 256 == 0 && MP >= MREAL, "row padding");

constexpr size_t MiB = 1u << 20;
constexpr size_t WS_CTL = 0;
constexpr size_t WS_WIN = 1 * MiB, WS_WOUT = 25 * MiB, WS_WGU = 33 * MiB, WS_WD = 77 * MiB;
constexpr size_t WS_XN = 99 * MiB;
constexpr size_t WS_A2 = 132 * MiB;
constexpr size_t WS_QS = 165 * MiB, WS_V = WS_QS + 16896 * 1024, WS_G = WS_V + 16896 * 1024, WS_U = WS_G + 16896 * 1024;
constexpr size_t WS_LF = 231 * MiB;
constexpr size_t WS_SB = 264 * MiB;
constexpr size_t WS_AC = 297 * MiB;
constexpr size_t WS_A4 = 165 * MiB;
constexpr size_t WS_END = 298 * MiB;
constexpr size_t WS_PART = WS_WIN;
static_assert(WS_A4 + (size_t)MP * FF * 2 <= WS_AC && WS_SB + (size_t)NITEM * 32768 <= WS_AC && WS_LF + (size_t)MP * 1024 * 4 <= WS_SB, "ws map");

constexpr int LDS_BYTES = 147456, LDS_MISC = 131072;
constexpr size_t WS_BAR = 256 * 1024, BAR_BYTES = 16384;
#define LAS __attribute__((address_space(3)))
typedef unsigned short bf16;
typedef unsigned v4u __attribute__((ext_vector_type(4)));
typedef unsigned v2u __attribute__((ext_vector_type(2)));
typedef float f32x4 __attribute__((ext_vector_type(4)));
typedef short bf16x8 __attribute__((ext_vector_type(8)));

__device__ __forceinline__ unsigned f2bf(float f) { unsigned u = __builtin_bit_cast(unsigned, f); return (u + 0x7fffu + ((u >> 16) & 1u)) >> 16; }
__device__ __forceinline__ unsigned pk2(float lo, float hi) { return f2bf(lo) | (f2bf(hi) << 16); }
__device__ __forceinline__ float bf2f(unsigned b) { return __builtin_bit_cast(float, b << 16); }
__device__ __forceinline__ float bflo(unsigned w) { return __builtin_bit_cast(float, w << 16); }
__device__ __forceinline__ float bfhi(unsigned w) { return __builtin_bit_cast(float, w & 0xffff0000u); }
__device__ __forceinline__ float sigmoidf_(float x) { return 1.f / (1.f + __expf(-x)); }
__device__ __forceinline__ float siluf_(float x) { return x / (1.f + __expf(-x)); }
__device__ __forceinline__ float wave_sum(float v) {
#pragma unroll
    for (int o = 1; o < 64; o <<= 1) v += __shfl_xor(v, o);
    return v;
}

struct Args { const float* in[19]; float* out; unsigned char* ws; int ph_lo, ph_hi; };
enum { I_XP = 0, I_XS, I_SH, I_SC, I_META, I_GMIX, I_WIN, I_LB, I_HG, I_CWT, I_CB, I_GNG, I_GNB, I_WOUT, I_GFFN, I_WG, I_WU, I_WD, I_GFIN };
constexpr size_t O_YP = 0, O_YS = (size_t)NB * SEQ * D, O_SHP = O_YS + (size_t)NS * D, O_SCP = O_SHP + (size_t)NB * NH * 128 * 128,
                 O_SHS = O_SCP + (size_t)NB * 30 * 1024, O_SCS = O_SHS + (size_t)NS * NH * 128 * 128, O_END = O_SCS + (size_t)NS * 30 * 1024;

struct RowMap { const float* xp; const float* xs; const float* meta; float* out; };
__device__ __forceinline__ const float* src_row(const RowMap& R, int r) {
    if (r >= MPROMPT) return R.xs + (size_t)(r - MPROMPT) * D;
    const int b = r / TP, t = r - b * TP;
    return t < NMETA ? R.meta + (size_t)t * D : R.xp + ((size_t)b * SEQ + (t - NMETA)) * D;
}
__device__ __forceinline__ float* out_row(const RowMap& R, int r) {
    if (r >= MPROMPT) return R.out + O_YS + (size_t)(r - MPROMPT) * D;
    const int b = r / TP, t = r - b * TP;
    return t < NMETA ? nullptr : R.out + O_YP + ((size_t)b * SEQ + (t - NMETA)) * D;
}

using pg8::Unit;
struct EpiIn {
    static constexpr bool PERM = true, AFTER_DRAIN = false;
    bf16* Qs; float* LF; bf16* V; bf16* G; bf16* U; const float* lbv;
    __device__ __forceinline__ void operator()(const f32x4 (&acc)[2][2][4][2], const Unit& u, int wr, int wc, int fr, int fq) const {
        const int row0 = u.pm * 256 + wr * 64 + fr;
        if (u.pn >= 16) {
            const int c0 = (u.pn - 16) * 128 + wc * 32 + 8 * fq;
#pragma unroll
            for (int ai = 0; ai < 2; ++ai)
#pragma unroll
                for (int m = 0; m < 4; ++m) {
                    const size_t row = (size_t)(row0 + ai * 128 + m * 16);
                    float o[8];
#pragma unroll
                    for (int n = 0; n < 2; ++n)
#pragma unroll
                        for (int j = 0; j < 4; ++j) o[n * 4 + j] = acc[ai][0][m][n][j] * sigmoidf_(acc[ai][1][m][n][j]);
                    v4u w; w.x = pg8::cvt_pk_bf16(o[0], o[1]); w.y = pg8::cvt_pk_bf16(o[2], o[3]); w.z = pg8::cvt_pk_bf16(o[4], o[5]); w.w = pg8::cvt_pk_bf16(o[6], o[7]);
                    *(v4u*)(U + row * 1024 + c0) = w;
                }
            return;
        }
        const int kind = u.pn >> 2, cb = (u.pn & 3) * 256 + wc * 32 + 8 * fq;
        if (kind == 1) {
            f32x4 lb[2][2];
#pragma unroll
            for (int bj = 0; bj < 2; ++bj)
#pragma unroll
                for (int n = 0; n < 2; ++n) lb[bj][n] = *(const f32x4*)(lbv + cb + bj * 128 + 4 * n);
#pragma unroll
            for (int ai = 0; ai < 2; ++ai)
#pragma unroll
                for (int m = 0; m < 4; ++m) {
                    const size_t row = (size_t)(row0 + ai * 128 + m * 16);
#pragma unroll
                    for (int bj = 0; bj < 2; ++bj)
#pragma unroll
                        for (int n = 0; n < 2; ++n) {
                            f32x4 o;
#pragma unroll
                            for (int j = 0; j < 4; ++j) { const float l = lb[bj][n][j]; o[j] = __logf(l + (1.f - l) * sigmoidf_(acc[ai][bj][m][n][j])); }
                            *(f32x4*)(LF + row * 1024 + cb + bj * 128 + 4 * n) = o;
                        }
                }
            return;
        }
        bf16* dst = Qs + (size_t)(kind == 0 ? 0 : kind - 1) * ((size_t)MP * 1024);
#pragma unroll
        for (int ai = 0; ai < 2; ++ai)
#pragma unroll
            for (int m = 0; m < 4; ++m) {
                const size_t row = (size_t)(row0 + ai * 128 + m * 16);
#pragma unroll
                for (int bj = 0; bj < 2; ++bj) {
                    float o[8];
#pragma unroll
                    for (int n = 0; n < 2; ++n)
#pragma unroll
                        for (int j = 0; j < 4; ++j) { const float x = acc[ai][bj][m][n][j]; o[n * 4 + j] = (kind == 2) ? x : siluf_(x); }
                    v4u w; w.x = pg8::cvt_pk_bf16(o[0], o[1]); w.y = pg8::cvt_pk_bf16(o[2], o[3]); w.z = pg8::cvt_pk_bf16(o[4], o[5]); w.w = pg8::cvt_pk_bf16(o[6], o[7]);
                    *(v4u*)(dst + row * 1024 + cb + bj * 128) = w;
                }
            }
    }
};

struct EpiOut {
    static constexpr bool PERM = true, AFTER_DRAIN = false;
    RowMap R; bf16* A3; const float* gffn; float* rowss;
    __device__ __forceinline__ void operator()(const f32x4 (&acc)[2][2][4][2], const Unit& u, int wr, int wc, int fr, int fq) const {
        const int row0 = u.pm * 256 + wr * 64 + fr, c0 = u.pn * 256 + wc * 32 + 8 * fq;
        f32x4 gv[2][2];
#pragma unroll
        for (int bj = 0; bj < 2; ++bj)
#pragma unroll
            for (int n = 0; n < 2; ++n) gv[bj][n] = *(const f32x4*)(gffn + c0 + bj * 128 + 4 * n);
#pragma unroll
        for (int ai = 0; ai < 2; ++ai)
#pragma unroll
            for (int m = 0; m < 4; ++m) {
                const int row = row0 + ai * 128 + m * 16;
                float ss = 0.f;
                if (row < MREAL) {
                    const float* src = src_row(R, row) + c0; float* dst = out_row(R, row);
#pragma unroll
                    for (int bj = 0; bj < 2; ++bj) {
                        f32x4 h[2];
#pragma unroll
                        for (int n = 0; n < 2; ++n) { h[n] = acc[ai][bj][m][n] + *(const f32x4*)(src + bj * 128 + 4 * n);
                            ss += (h[n][0] * h[n][0] + h[n][1] * h[n][1]) + (h[n][2] * h[n][2] + h[n][3] * h[n][3]);
                            if (dst) *(f32x4*)(dst + c0 + bj * 128 + 4 * n) = h[n]; }
                        const f32x4 a = h[0] * gv[bj][0], b = h[1] * gv[bj][1];
                        v4u w; w.x = pg8::cvt_pk_bf16(a[0], a[1]); w.y = pg8::cvt_pk_bf16(a[2], a[3]); w.z = pg8::cvt_pk_bf16(b[0], b[1]); w.w = pg8::cvt_pk_bf16(b[2], b[3]);
                        *(v4u*)(A3 + (size_t)row * D + c0 + bj * 128) = w;
                    }
                }
                ss += __shfl_xor(ss, 16); ss += __shfl_xor(ss, 32);
                if (fq == 0 && row < MREAL) atomicAdd(rowss + row, ss);
            }
    }
};

struct EpiGU {
    static constexpr bool PERM = true, AFTER_DRAIN = false;
    const float* rowss; bf16* A4;
    __device__ __forceinline__ void operator()(const f32x4 (&acc)[2][2][4][2], const Unit& u, int wr, int wc, int fr, int fq) const {
        const int row0 = u.pm * 256 + wr * 64 + fr, c0 = u.pn * 128 + wc * 32 + 8 * fq;
#pragma unroll
        for (int ai = 0; ai < 2; ++ai)
#pragma unroll
            for (int m = 0; m < 4; ++m) {
                const int row = row0 + ai * 128 + m * 16;
                const float rstd = rsqrtf(rowss[row] * (1.f / D) + EPS);
                float o[8];
#pragma unroll
                for (int n = 0; n < 2; ++n)
#pragma unroll
                    for (int j = 0; j < 4; ++j) o[n * 4 + j] = siluf_(acc[ai][0][m][n][j] * rstd) * (acc[ai][1][m][n][j] * rstd);
                v4u w; w.x = pg8::cvt_pk_bf16(o[0], o[1]); w.y = pg8::cvt_pk_bf16(o[2], o[3]); w.z = pg8::cvt_pk_bf16(o[4], o[5]); w.w = pg8::cvt_pk_bf16(o[6], o[7]);
                *(v4u*)(A4 + (size_t)row * FF + c0) = w;
            }
    }
};

constexpr int MAIN_ROWS = 8192, NSLICE = 11, SLICE_NT = 8;
static_assert(NSLICE * SLICE_NT * 64 == FF && MAIN_ROWS + 256 == MP, "down-proj split");
struct SplitOrder : pg8::StaticOrder {
    __host__ __device__ bool next(int i, Unit& u) const {
        const long L = (long)i * G + c;
        if (L < nwg) return pg8::StaticOrder::next(i, u);
        const int j = (int)(L - nwg); if (j >= NSLICE * (D / 256)) return false;
        u.pm = MAIN_ROWS / 256; u.pn = j & 7; u.k0 = (j >> 3) * (SLICE_NT * 64); u.nt = SLICE_NT; return true;
    }
};
struct EpiDown {
    static constexpr bool PERM = true, AFTER_DRAIN = false;
    RowMap R; float* part;
    __device__ __forceinline__ void operator()(const f32x4 (&acc)[2][2][4][2], const Unit& u, int wr, int wc, int fr, int fq) const {
        const int c0 = u.pn * 256 + wc * 32 + 8 * fq;
        if (u.nt == SLICE_NT) {
            float* pb = part + ((size_t)(u.k0 / (SLICE_NT * 64)) * 256 + wr * 64 + fr) * D + c0;
#pragma unroll
            for (int ai = 0; ai < 2; ++ai)
#pragma unroll
                for (int m = 0; m < 4; ++m)
#pragma unroll
                    for (int bj = 0; bj < 2; ++bj)
#pragma unroll
                        for (int n = 0; n < 2; ++n) *(f32x4*)(pb + (size_t)(ai * 128 + m * 16) * D + bj * 128 + 4 * n) = acc[ai][bj][m][n];
            return;
        }
        const int row0 = u.pm * 256 + wr * 64 + fr;
#pragma unroll
        for (int ai = 0; ai < 2; ++ai)
#pragma unroll
            for (int m = 0; m < 4; ++m) {
                const int row = row0 + ai * 128 + m * 16;
                float* dst = row < MREAL ? out_row(R, row) : nullptr;
                if (dst) {
#pragma unroll
                    for (int bj = 0; bj < 2; ++bj)
#pragma unroll
                        for (int n = 0; n < 2; ++n) { f32x4* p = (f32x4*)(dst + c0 + bj * 128 + 4 * n); *p = *p + acc[ai][bj][m][n]; }
                }
            }
    }
};

__device__ __forceinline__ void p0_transpose_item(const float* W, int K, int N, bf16* WT, int k0, int n0, int drow0, LAS float* scr, int lane) {
#pragma unroll 8
    for (int i = 0; i < 32; ++i) { const int kk = 2 * i + (lane >> 5); scr[kk * 33 + (lane & 31)] = W[(size_t)(k0 + kk) * N + n0 + (lane & 31)]; }
    asm volatile("s_waitcnt lgkmcnt(0)" ::: "memory");
    const int c = lane & 7;
#pragma unroll
    for (int j = 0; j < 4; ++j) { const int n = (lane >> 3) + 8 * j; const LAS float* s = scr + (8 * c) * 33 + n;
        v4u o; o.x = pk2(s[0 * 33], s[1 * 33]); o.y = pk2(s[2 * 33], s[3 * 33]); o.z = pk2(s[4 * 33], s[5 * 33]); o.w = pk2(s[6 * 33], s[7 * 33]);
        *(v4u*)(WT + (size_t)(drow0 + n) * K + k0 + 8 * c) = o; }
    asm volatile("s_waitcnt lgkmcnt(0)" ::: "memory");
}
__device__ __forceinline__ int glu_row(int n0) {
    if (n0 < 4096) return n0;
    if (n0 < 5120) { const int c = n0 - 4096; return 4096 + (c >> 7) * 256 + (c & 127); }
    const int c = n0 - 5120; return 4096 + (c >> 7) * 256 + 128 + (c & 127);
}
constexpr int I_IN = (D / 64) * (NIN / 32), I_OUT = (D / 64) * (D / 32), I_G = (D / 64) * (FF / 32), I_DN = (FF / 64) * (D / 32);
constexpr int CV_A = I_IN, CV_B = I_IN + I_OUT + 2 * I_G, CV_END = CV_B + I_DN;
__device__ __forceinline__ void convert_weights(const Args& a, LAS unsigned char* lds, int lane, int wave, int lo, int hi, int ww, int nww) {
    unsigned char* ws = a.ws;
    LAS float* scr = (LAS float*)(lds + wave * 16384);
    for (int it = lo + ww; it < hi; it += nww) {
        int r = it;
        if (r < I_IN) { const int nblk = NIN / 32, kb = r / nblk, nb = r % nblk; p0_transpose_item(a.in[I_WIN], D, NIN, (bf16*)(ws + WS_WIN), 64 * kb, 32 * nb, glu_row(32 * nb), scr, lane); continue; } r -= I_IN;
        if (r < I_OUT) { const int nblk = D / 32, kb = r / nblk, nb = r % nblk; p0_transpose_item(a.in[I_WOUT], D, D, (bf16*)(ws + WS_WOUT), 64 * kb, 32 * nb, 32 * nb, scr, lane); continue; } r -= I_OUT;
        if (r < I_G) { const int nblk = FF / 32, kb = r / nblk, nb = r % nblk, n0 = 32 * nb; p0_transpose_item(a.in[I_WG], D, FF, (bf16*)(ws + WS_WGU), 64 * kb, n0, (n0 >> 7) * 256 + (n0 & 127), scr, lane); continue; } r -= I_G;
        if (r < I_G) { const int nblk = FF / 32, kb = r / nblk, nb = r % nblk, n0 = 32 * nb; p0_transpose_item(a.in[I_WU], D, FF, (bf16*)(ws + WS_WGU), 64 * kb, n0, (n0 >> 7) * 256 + 128 + (n0 & 127), scr, lane); continue; } r -= I_G;
        { const int nblk = D / 32, kb = r / nblk, nb = r % nblk; p0_transpose_item(a.in[I_WD], FF, D, (bf16*)(ws + WS_WD), 64 * kb, 32 * nb, 32 * nb, scr, lane); }
    }
}
__device__ __forceinline__ void idle_slot_convert(const Args& a, LAS unsigned char* lds, int lane, int wave, int nunits, int lo, int hi) {
    const int G = gridDim.x, rem = nunits % G, c = blockIdx.x;
    if (rem == 0) convert_weights(a, lds, lane, wave, lo, hi, c * 8 + wave, G * 8);
    else if (c >= rem) convert_weights(a, lds, lane, wave, lo, hi, (c - rem) * 8 + wave, (G - rem) * 8);
}
__device__ __forceinline__ void p0_prologue(const Args& a, LAS unsigned char* lds, int tid, int lane, int wave) {
    unsigned char* ws = a.ws;
    const int gw = blockIdx.x * 8 + wave, NGW = gridDim.x * 8;
    convert_weights(a, lds, lane, wave, 0, CV_A, gw, NGW);
    RowMap R{a.in[I_XP], a.in[I_XS], a.in[I_META], a.out};
    const float* gm = a.in[I_GMIX]; bf16* XN = (bf16*)(ws + WS_XN);
    for (int m = gw; m < MP; m += NGW) {
        v4u* o = (v4u*)(XN + (size_t)m * D) + lane;
        if (m >= MREAL) {
#pragma unroll
            for (int j = 0; j < 4; ++j) o[64 * j] = (v4u){0u, 0u, 0u, 0u};
            continue; }
        const f32x4* xr = (const f32x4*)src_row(R, m);
        f32x4 v[8]; float s = 0.f;
#pragma unroll
        for (int j = 0; j < 4; ++j) { v[2 * j] = xr[2 * lane + 128 * j]; v[2 * j + 1] = xr[2 * lane + 128 * j + 1]; }
#pragma unroll
        for (int j = 0; j < 8; ++j) s += (v[j][0] * v[j][0] + v[j][1] * v[j][1]) + (v[j][2] * v[j][2] + v[j][3] * v[j][3]);
        const float rstd = rsqrtf(wave_sum(s) * (1.f / D) + EPS);
#pragma unroll
        for (int j = 0; j < 4; ++j) { const f32x4 g0 = ((const f32x4*)gm)[2 * lane + 128 * j], g1 = ((const f32x4*)gm)[2 * lane + 128 * j + 1];
            const f32x4 a0 = v[2 * j] * rstd * g0, a1 = v[2 * j + 1] * rstd * g1;
            v4u w; w.x = pk2(a0[0], a0[1]); w.y = pk2(a0[2], a0[3]); w.z = pk2(a1[0], a1[1]); w.w = pk2(a1[2], a1[3]);
            o[64 * j] = w; }
    }
    float* ctl = (float*)(ws + WS_CTL);
    for (int i = blockIdx.x * 512 + tid; i < AW; i += gridDim.x * 512) { const float l0 = a.in[I_LB][i], l1 = a.in[I_LB][AW + i]; const float mx = fmaxf(l0, l1);
        const float e0 = __expf(l0 - mx), e1 = __expf(l1 - mx); ctl[i] = e0 / (e0 + e1); }
    for (int i = blockIdx.x * 512 + tid; i < MP; i += gridDim.x * 512) { ctl[16384 + i] = 0.f; ctl[32768 + i] = 0.f; }
}

constexpr int L_KT2 = 2048, L_TOT = 0, L_QP = 2048, L_QT = 19456, L_KT = 36864, L_VT = 54272, L_ST = 72704, L_PM = 107520, L_OB = 19456;
constexpr int RS_K = 136, RS_S = 72;
__device__ __forceinline__ void chunk_rows(int it, int& rowbase, int& nvalid, int& col0) {
    const int c = it % NCHUNK, bh = it / NCHUNK, h = bh & 7, b = bh >> 3;
    col0 = h * 128;
    if (c == 0) { rowbase = b * TP; nvalid = NMETA; } else { rowbase = b * TP + NMETA + (c - 1) * 64; nvalid = 64; }
}
__device__ __forceinline__ bf16x8 lds_frag(const LAS unsigned char* p) { return *(const LAS bf16x8*)p; }


__device__ __forceinline__ void hl_load(const float* LF, const bf16* V, int it, int c_, int seg, float (&lf)[16], unsigned short (&vr)[16]) {
    int rowbase, nvalid, col0; chunk_rows(it, rowbase, nvalid, col0);
    const size_t base = (size_t)(rowbase + seg * 16) * 1024 + col0 + c_;
#pragma unroll
    for (int i = 0; i < 16; ++i) { lf[i] = LF[base + (size_t)i * 1024]; vr[i] = V[base + (size_t)i * 1024]; }
}
__device__ __forceinline__ void hgrn_local(const Args& a, LAS unsigned char* lds, int tid, int lane, int wave) {
    unsigned char* ws = a.ws;
    const float* LF = (const float*)(ws + WS_LF); const bf16* V = (const bf16*)(ws + WS_V);
    bf16* SB = (bf16*)(ws + WS_SB); float* AC = (float*)(ws + WS_AC);
    LAS float* tot = (LAS float*)(lds + L_TOT);
    const int c_ = tid & 127, seg = tid >> 7, G = gridDim.x;
    float nlf[16]; unsigned short nvr[16];
    int it = blockIdx.x;
    if (it < NITEM) hl_load(LF, V, it, c_, seg, nlf, nvr);
    for (; it < NITEM; it += G) {
        int rowbase, nvalid, col0; chunk_rows(it, rowbase, nvalid, col0);
        float lf[16], pre[16]; unsigned vv[8];
#pragma unroll
        for (int i = 0; i < 16; ++i) lf[i] = (seg * 16 + i) < nvalid ? nlf[i] : 0.f;
#pragma unroll
        for (int i = 0; i < 8; ++i) { const int s = seg * 16 + 2 * i; vv[i] = (s < nvalid ? (unsigned)nvr[2 * i] : 0u) | ((s + 1 < nvalid ? (unsigned)nvr[2 * i + 1] : 0u) << 16); }
        float run = 0.f;
#pragma unroll
        for (int i = 0; i < 16; ++i) { run += lf[i]; pre[i] = run; }
        tot[seg * 128 + c_] = run;
        __syncthreads();
        if (it + G < NITEM) hl_load(LF, V, it + G, c_, seg, nlf, nvr);
        const float t0 = tot[c_], t1 = tot[128 + c_], t2 = tot[256 + c_], t3 = tot[384 + c_];
        const float off = seg == 0 ? 0.f : (seg == 1 ? t0 : (seg == 2 ? t0 + t1 : t0 + t1 + t2)), blast = (t0 + t1) + (t2 + t3);
        unsigned kk[8];
#pragma unroll
        for (int i = 0; i < 8; ++i) {
            const float k0 = (1.f - __expf(lf[2 * i])) * __expf(blast - (off + pre[2 * i])), k1 = (1.f - __expf(lf[2 * i + 1])) * __expf(blast - (off + pre[2 * i + 1]));
            kk[i] = pk2(k0, k1); }
        LAS unsigned char* kt = lds + L_KT2 + c_ * (RS_S * 2) + seg * 32;
        LAS unsigned char* vt = lds + L_VT + c_ * (RS_S * 2) + seg * 32;
        *(LAS v4u*)kt = (v4u){kk[0], kk[1], kk[2], kk[3]}; *(LAS v4u*)(kt + 16) = (v4u){kk[4], kk[5], kk[6], kk[7]};
        *(LAS v4u*)vt = (v4u){vv[0], vv[1], vv[2], vv[3]}; *(LAS v4u*)(vt + 16) = (v4u){vv[4], vv[5], vv[6], vv[7]};
        if (seg == 0) AC[(size_t)it * 128 + c_] = __expf(blast);
        __syncthreads();
        const int r = lane & 15, q = lane >> 4;
        f32x4 acc[8];
#pragma unroll
        for (int n = 0; n < 8; ++n) acc[n] = (f32x4){0.f, 0.f, 0.f, 0.f};
#pragma unroll
        for (int ks = 0; ks < 2; ++ks) {
            const bf16x8 af = lds_frag(lds + L_KT2 + (wave * 16 + r) * (RS_S * 2) + (ks * 32 + q * 8) * 2);
#pragma unroll
            for (int n = 0; n < 8; ++n) { const bf16x8 bfm = lds_frag(lds + L_VT + (n * 16 + r) * (RS_S * 2) + (ks * 32 + q * 8) * 2);
                acc[n] = __builtin_amdgcn_mfma_f32_16x16x32_bf16(af, bfm, acc[n], 0, 0, 0); }
        }
        bf16* bt = SB + (size_t)it * 16384;
#pragma unroll
        for (int n = 0; n < 8; ++n) { v2u w; w.x = pk2(acc[n][0], acc[n][1]); w.y = pk2(acc[n][2], acc[n][3]);
            *(v2u*)(bt + (n * 16 + r) * 128 + wave * 16 + 4 * q) = w; }
        __syncthreads();
    }
}

__device__ __forceinline__ void hgrn_scan(const Args& a, int tid) {
    unsigned char* ws = a.ws; bf16* SB = (bf16*)(ws + WS_SB); const float* AC = (const float*)(ws + WS_AC);
    float* outS = a.out + O_SHP;
    for (int g = blockIdx.x * 512 + tid; g < NB * NH * 128 * 32; g += gridDim.x * 512) {
        const int bh = g >> 12, rem = g & 4095, v = rem >> 5, k4 = rem & 31;
        float S0 = 0.f, S1 = 0.f, S2 = 0.f, S3 = 0.f;
#pragma unroll 11
        for (int c = 0; c < NCHUNK; ++c) {
            const size_t it = (size_t)bh * NCHUNK + c;
            const f32x4 dec = *(const f32x4*)(AC + it * 128 + 4 * k4);
            v2u* p = (v2u*)(SB + it * 16384 + v * 128 + 4 * k4);
            const v2u bw = *p;
            v2u sw; sw.x = pk2(S0, S1); sw.y = pk2(S2, S3); *p = sw;
            S0 = dec[0] * S0 + bflo(bw.x); S1 = dec[1] * S1 + bfhi(bw.x); S2 = dec[2] * S2 + bflo(bw.y); S3 = dec[3] * S3 + bfhi(bw.y);
        }
        float* o = outS + ((size_t)bh * 128 + 4 * k4) * 128 + v;
        o[0] = S0; o[128] = S1; o[256] = S2; o[384] = S3;
    }
}

struct HoPre { float lf[16]; unsigned short vr[16], qr[16]; v4u st[4]; v4u g[2]; f32x4 hg[4]; };
__device__ __forceinline__ void ho_load(const float* LF, const bf16* V, const bf16* Qs, const bf16* G, const bf16* SB, const float* hgp, int it, int tid, HoPre& P) {
    int rowbase, nvalid, col0; chunk_rows(it, rowbase, nvalid, col0);
    const int c_ = tid & 127, seg = tid >> 7;
    const size_t base = (size_t)(rowbase + seg * 16) * 1024 + col0 + c_;
#pragma unroll
    for (int i = 0; i < 16; ++i) { P.lf[i] = LF[base + (size_t)i * 1024]; P.vr[i] = V[base + (size_t)i * 1024]; P.qr[i] = Qs[base + (size_t)i * 1024]; }
    const v4u* sp = (const v4u*)(SB + (size_t)it * 16384);
#pragma unroll
    for (int j = 0; j < 4; ++j) P.st[j] = sp[tid + 512 * j];
    const int t = tid >> 3, v0 = (tid & 7) * 16;
    const v4u* gp = (const v4u*)(G + (size_t)(rowbase + t) * 1024 + col0 + v0); P.g[0] = gp[0]; P.g[1] = gp[1];
    const f32x4* hp = (const f32x4*)(hgp + col0 + v0);
#pragma unroll
    for (int j = 0; j < 4; ++j) P.hg[j] = hp[j];
}
__device__ __forceinline__ void hgrn_out(const Args& a, LAS unsigned char* lds, int tid, int lane, int wave) {
    unsigned char* ws = a.ws;
    const float* LF = (const float*)(ws + WS_LF); const bf16* V = (const bf16*)(ws + WS_V); const bf16* Qs = (const bf16*)(ws + WS_QS); const bf16* G = (const bf16*)(ws + WS_G);
    const bf16* SB = (const bf16*)(ws + WS_SB); bf16* A2 = (bf16*)(ws + WS_A2); const float* hg = a.in[I_HG];
    LAS float* tot = (LAS float*)(lds + L_TOT);
    const int c_ = tid & 127, seg = tid >> 7, Gd = gridDim.x;
    HoPre P;
    int it = blockIdx.x;
    if (it < NITEM) ho_load(LF, V, Qs, G, SB, hg, it, tid, P);
    for (; it < NITEM; it += Gd) {
        int rowbase, nvalid, col0; chunk_rows(it, rowbase, nvalid, col0);
        float lf[16], pre[16], qv[16];
#pragma unroll
        for (int i = 0; i < 16; ++i) { const bool ok = (seg * 16 + i) < nvalid; lf[i] = ok ? P.lf[i] : 0.f; qv[i] = ok ? bf2f(P.qr[i]) : 0.f; }
        float run = 0.f;
#pragma unroll
        for (int i = 0; i < 16; ++i) { run += lf[i]; pre[i] = run; }
        tot[seg * 128 + c_] = run;
        { unsigned vv[8];
#pragma unroll
          for (int i = 0; i < 8; ++i) { const int s = seg * 16 + 2 * i; vv[i] = (s < nvalid ? (unsigned)P.vr[2 * i] : 0u) | ((s + 1 < nvalid ? (unsigned)P.vr[2 * i + 1] : 0u) << 16); }
          LAS unsigned char* vt = lds + L_VT + c_ * (RS_S * 2) + seg * 32;
          *(LAS v4u*)vt = (v4u){vv[0], vv[1], vv[2], vv[3]}; *(LAS v4u*)(vt + 16) = (v4u){vv[4], vv[5], vv[6], vv[7]}; }
#pragma unroll
        for (int j = 0; j < 4; ++j) { const int id = tid + 512 * j, v = id >> 4, kc = id & 15; *(LAS v4u*)(lds + L_ST + v * (RS_K * 2) + kc * 16) = P.st[j]; }
        const v4u gw0 = P.g[0], gw1 = P.g[1]; const f32x4 hg0 = P.hg[0], hg1 = P.hg[1], hg2 = P.hg[2], hg3 = P.hg[3];
        __syncthreads();
        if (it + Gd < NITEM) ho_load(LF, V, Qs, G, SB, hg, it + Gd, tid, P);
        const float t0 = tot[c_], t1 = tot[128 + c_], t2 = tot[256 + c_];
        const float off = seg == 0 ? 0.f : (seg == 1 ? t0 : (seg == 2 ? t0 + t1 : t0 + t1 + t2)), bref = t0 + t1;
#pragma unroll
        for (int i = 0; i < 16; ++i) {
            const int s = seg * 16 + i; const float b = off + pre[i];
            const float qp = qv[i] * __expf(b), qt = qv[i] * __expf(fminf(b - bref, 80.f)), kt = (1.f - __expf(lf[i])) * __expf(fminf(bref - b, 80.f));
            ((LAS bf16*)(lds + L_QP))[s * RS_K + c_] = (bf16)f2bf(qp);
            ((LAS bf16*)(lds + L_QT))[s * RS_K + c_] = (bf16)f2bf(qt);
            ((LAS bf16*)(lds + L_KT))[s * RS_K + c_] = (bf16)f2bf(kt);
        }
        __syncthreads();
        const int r = lane & 15, q = lane >> 4;
        {
            const int sb = wave & 3, tb0 = (wave >> 2) * 2;
            f32x4 sc[2] = {(f32x4){0.f, 0.f, 0.f, 0.f}, (f32x4){0.f, 0.f, 0.f, 0.f}};
#pragma unroll
            for (int ks = 0; ks < 4; ++ks) {
                const bf16x8 af = lds_frag(lds + L_KT + (sb * 16 + r) * (RS_K * 2) + (ks * 32 + q * 8) * 2);
#pragma unroll
                for (int n = 0; n < 2; ++n) { const bf16x8 bfm = lds_frag(lds + L_QT + ((tb0 + n) * 16 + r) * (RS_K * 2) + (ks * 32 + q * 8) * 2);
                    sc[n] = __builtin_amdgcn_mfma_f32_16x16x32_bf16(af, bfm, sc[n], 0, 0, 0); }
            }
#pragma unroll
            for (int n = 0; n < 2; ++n) { const int t = (tb0 + n) * 16 + r, s0 = sb * 16 + 4 * q;
                const float p0 = s0 <= t ? sc[n][0] : 0.f, p1 = s0 + 1 <= t ? sc[n][1] : 0.f, p2 = s0 + 2 <= t ? sc[n][2] : 0.f, p3 = s0 + 3 <= t ? sc[n][3] : 0.f;
                v2u w; w.x = pk2(p0, p1); w.y = pk2(p2, p3);
                *(LAS v2u*)(lds + L_PM + t * (RS_S * 2) + s0 * 2) = w; }
        }
        __syncthreads();
        {
            const int tb = wave & 3, nv0 = (wave >> 2) * 4;
            f32x4 oc[4];
#pragma unroll
            for (int n = 0; n < 4; ++n) oc[n] = (f32x4){0.f, 0.f, 0.f, 0.f};
#pragma unroll
            for (int ks = 0; ks < 2; ++ks) {
                const bf16x8 af = lds_frag(lds + L_PM + (tb * 16 + r) * (RS_S * 2) + (ks * 32 + q * 8) * 2);
#pragma unroll
                for (int n = 0; n < 4; ++n) { const bf16x8 bfm = lds_frag(lds + L_VT + ((nv0 + n) * 16 + r) * (RS_S * 2) + (ks * 32 + q * 8) * 2);
                    oc[n] = __builtin_amdgcn_mfma_f32_16x16x32_bf16(af, bfm, oc[n], 0, 0, 0); }
            }
#pragma unroll
            for (int ks = 0; ks < 4; ++ks) {
                const bf16x8 af = lds_frag(lds + L_QP + (tb * 16 + r) * (RS_K * 2) + (ks * 32 + q * 8) * 2);
#pragma unroll
                for (int n = 0; n < 4; ++n) { const bf16x8 bfm = lds_frag(lds + L_ST + ((nv0 + n) * 16 + r) * (RS_K * 2) + (ks * 32 + q * 8) * 2);
                    oc[n] = __builtin_amdgcn_mfma_f32_16x16x32_bf16(af, bfm, oc[n], 0, 0, 0); }
            }
#pragma unroll
            for (int n = 0; n < 4; ++n)
#pragma unroll
                for (int j = 0; j < 4; ++j) ((LAS float*)(lds + L_OB))[(tb * 16 + 4 * q + j) * 132 + (nv0 + n) * 16 + r] = oc[n][j];
        }
        __syncthreads();
        {
            const int t = tid >> 3, part = tid & 7, v0 = part * 16;
            const LAS f32x4* op = (const LAS f32x4*)(lds + L_OB + (t * 132 + v0) * 4);
            f32x4 o4[4]; float ss = 0.f;
#pragma unroll
            for (int j = 0; j < 4; ++j) { o4[j] = op[j]; ss += (o4[j][0] * o4[j][0] + o4[j][1] * o4[j][1]) + (o4[j][2] * o4[j][2] + o4[j][3] * o4[j][3]); }
            ss += __shfl_xor(ss, 1); ss += __shfl_xor(ss, 2); ss += __shfl_xor(ss, 4);
            const float rstd = rsqrtf(ss * (1.f / 128.f) + EPS);
            if (t < nvalid) {
                v4u* dst = (v4u*)(A2 + (size_t)(rowbase + t) * D + col0 + v0);
                { const f32x4 x0 = o4[0] * rstd * hg0, x1 = o4[1] * rstd * hg1; v4u w;
                  w.x = pk2(x0[0] * bflo(gw0.x), x0[1] * bfhi(gw0.x)); w.y = pk2(x0[2] * bflo(gw0.y), x0[3] * bfhi(gw0.y));
                  w.z = pk2(x1[0] * bflo(gw0.z), x1[1] * bfhi(gw0.z)); w.w = pk2(x1[2] * bflo(gw0.w), x1[3] * bfhi(gw0.w)); dst[0] = w; }
                { const f32x4 x0 = o4[2] * rstd * hg2, x1 = o4[3] * rstd * hg3; v4u w;
                  w.x = pk2(x0[0] * bflo(gw1.x), x0[1] * bfhi(gw1.x)); w.y = pk2(x0[2] * bflo(gw1.y), x0[3] * bfhi(gw1.y));
                  w.z = pk2(x1[0] * bflo(gw1.z), x1[1] * bfhi(gw1.z)); w.w = pk2(x1[2] * bflo(gw1.w), x1[3] * bfhi(gw1.w)); dst[1] = w; }
            }
        }
        __syncthreads();
    }
}

constexpr int L_CT = 0, L_CS = 34816, CT_RS = 260;
__device__ __forceinline__ void cp_load(const bf16* U, int pr, int ch, int half, unsigned short (&ur)[46]) {
    constexpr int NTT = (TP + 31) / 32;
    const int tt = pr % NTT, b = pr / NTT, t0 = tt * 32 + half * 16;
#pragma unroll
    for (int j = 0; j < 46; ++j) { int tok = t0 - 30 + j; tok = tok < 0 ? 0 : (tok > TP - 1 ? TP - 1 : tok); ur[j] = U[(size_t)(b * TP + tok) * 1024 + ch]; }
}
__device__ __forceinline__ void conv_prompt(const Args& a, LAS unsigned char* lds, int tid, int lane, int wave) {
    unsigned char* ws = a.ws; const bf16* U = (const bf16*)(ws + WS_U); bf16* A2 = (bf16*)(ws + WS_A2);
    const float* cw = a.in[I_CWT];
    constexpr int NTT = (TP + 31) / 32, NPR = NB * NTT;
    LAS float* CT = (LAS float*)(lds + L_CT); LAS float* CS = (LAS float*)(lds + L_CS);
    {
        const int cbk = blockIdx.x & 3, cl = tid & 255, ch = cbk * 256 + cl, half = tid >> 8, stride = gridDim.x >> 2;
        float w[CW];
#pragma unroll
        for (int j = 0; j < CW; ++j) w[j] = cw[j * 1024 + ch];
        const float bias = a.in[I_CB][ch], gg = a.in[I_GNG][ch], gb = a.in[I_GNB][ch];
        unsigned short ur[46];
        int pr = blockIdx.x >> 2;
        if (pr < NPR) cp_load(U, pr, ch, half, ur);
        for (; pr < NPR; pr += stride) {
            const int tt = pr % NTT, b = pr / NTT, t0 = tt * 32 + half * 16;
            float uw[46];
#pragma unroll
            for (int j = 0; j < 46; ++j) { const int tok = t0 - 30 + j; uw[j] = (tok >= 0 && tok < TP) ? bf2f(ur[j]) : 0.f; }
            float c[16];
#pragma unroll
            for (int i = 0; i < 16; ++i) { float s = bias;
#pragma unroll
                for (int j = 0; j < CW; ++j) s += w[j] * uw[i + j];
                c[i] = s; CT[(half * 16 + i) * CT_RS + cl] = s; }
            __syncthreads();
            if (pr + stride < NPR) cp_load(U, pr + stride, ch, half, ur);
            {
                const int tok = tid >> 4, sub = tid & 15;
                const LAS f32x4* p = (const LAS f32x4*)(CT + tok * CT_RS + sub * 16);
                float s1 = 0.f, s2 = 0.f;
#pragma unroll
                for (int k = 0; k < 4; ++k) { const f32x4 x = p[k]; s1 += (x[0] + x[1]) + (x[2] + x[3]); s2 += (x[0] * x[0] + x[1] * x[1]) + (x[2] * x[2] + x[3] * x[3]); }
                s1 += __shfl_xor(s1, 1); s2 += __shfl_xor(s2, 1); s1 += __shfl_xor(s1, 2); s2 += __shfl_xor(s2, 2); s1 += __shfl_xor(s1, 4); s2 += __shfl_xor(s2, 4);
                if ((tid & 7) == 0) { const float mu = s1 * (1.f / 128.f), var = fmaxf(s2 * (1.f / 128.f) - mu * mu, 0.f);
                    CS[(tok * 2 + (sub >> 3)) * 2] = mu; CS[(tok * 2 + (sub >> 3)) * 2 + 1] = rsqrtf(var + EPS); }
            }
            __syncthreads();
            const int grp = cl >> 7;
#pragma unroll
            for (int i = 0; i < 16; ++i) {
                const int tl = half * 16 + i; const float mu = CS[(tl * 2 + grp) * 2], rs = CS[(tl * 2 + grp) * 2 + 1];
                const float cn = (c[i] - mu) * rs * gg + gb;
                const int tok = t0 + i;
                if (tok < TP) A2[(size_t)(b * TP + tok) * D + 1024 + ch] = (bf16)f2bf(siluf_(cn));
            }
        }
    }
    float* o = a.out + O_SCP;
    for (int i = blockIdx.x * 512 + tid; i < NB * 30 * 1024; i += gridDim.x * 512) { const int ch = i & 1023, j = (i >> 10) % 30, b = (i >> 10) / 30;
        o[i] = bf2f(U[(size_t)(b * TP + TP - 30 + j) * 1024 + ch]); }
}
__device__ __forceinline__ void conv_sample_wave(const Args& a, int item, int lane) {
    unsigned char* ws = a.ws; const bf16* U = (const bf16*)(ws + WS_U); bf16* A2 = (bf16*)(ws + WS_A2);
    typedef float f32x2 __attribute__((ext_vector_type(2)));
    const int sb = item >> 3, ch = (item & 7) * 128 + 2 * lane;
    const float* cw = a.in[I_CWT] + ch; const float* st = a.in[I_SC] + (size_t)sb * 30 * 1024 + ch; float* ot = a.out + O_SCS + (size_t)sb * 30 * 1024 + ch;
    const unsigned uw = *(const unsigned*)(U + (size_t)(MPROMPT + sb) * 1024 + ch);
    f32x2 x[30];
#pragma unroll
    for (int j = 0; j < 30; ++j) x[j] = *(const f32x2*)(st + j * 1024);
    f32x2 s = *(const f32x2*)(a.in[I_CB] + ch);
#pragma unroll
    for (int j = 0; j < 30; ++j) { s += *(const f32x2*)(cw + j * 1024) * x[j]; if (j >= 1) *(f32x2*)(ot + (j - 1) * 1024) = x[j]; }
    const f32x2 un = (f32x2){bflo(uw), bfhi(uw)};
    s += *(const f32x2*)(cw + 30 * 1024) * un; *(f32x2*)(ot + 29 * 1024) = un;
    const float s1 = wave_sum(s[0] + s[1]), s2 = wave_sum(s[0] * s[0] + s[1] * s[1]);
    const float mu = s1 * (1.f / 128.f), rs = rsqrtf(fmaxf(s2 * (1.f / 128.f) - mu * mu, 0.f) + EPS);
    const f32x2 gg = *(const f32x2*)(a.in[I_GNG] + ch), gb = *(const f32x2*)(a.in[I_GNB] + ch);
    const float c0 = (s[0] - mu) * rs * gg[0] + gb[0], c1 = (s[1] - mu) * rs * gg[1] + gb[1];
    *(unsigned*)(A2 + (size_t)(MPROMPT + sb) * D + 1024 + ch) = pk2(siluf_(c0), siluf_(c1));
}
__device__ __forceinline__ void hgrn_sample_wave(const Args& a, int item, int lane) {
    unsigned char* ws = a.ws;
    typedef float f32x2 __attribute__((ext_vector_type(2)));
    const float* LF = (const float*)(ws + WS_LF); const bf16* V = (const bf16*)(ws + WS_V); const bf16* Qs = (const bf16*)(ws + WS_QS); const bf16* G = (const bf16*)(ws + WS_G);
    bf16* A2 = (bf16*)(ws + WS_A2);
    const int sb = item >> 3, h = item & 7; const size_t rb = (size_t)(MPROMPT + sb) * 1024 + h * 128;
    const float* sp = a.in[I_SH] + (size_t)item * 16384 + 2 * lane; float* so = a.out + O_SHS + (size_t)item * 16384 + 2 * lane;
    float qa[2], fa[2], ka[2];
#pragma unroll
    for (int hh = 0; hh < 2; ++hh) { const float f = __expf(LF[rb + hh * 64 + lane]); qa[hh] = bf2f(Qs[rb + hh * 64 + lane]); fa[hh] = f; ka[hh] = 1.f - f; }
    const unsigned vw = *(const unsigned*)(V + rb + 2 * lane);
    const f32x2 vv = (f32x2){bflo(vw), bfhi(vw)};
    f32x2 o = (f32x2){0.f, 0.f};
#pragma unroll
    for (int hh = 0; hh < 2; ++hh) {
#pragma unroll 16
        for (int k = 0; k < 64; ++k) {
            const float qk = __builtin_bit_cast(float, __builtin_amdgcn_readlane(__builtin_bit_cast(int, qa[hh]), k));
            const float fk = __builtin_bit_cast(float, __builtin_amdgcn_readlane(__builtin_bit_cast(int, fa[hh]), k));
            const float kk = __builtin_bit_cast(float, __builtin_amdgcn_readlane(__builtin_bit_cast(int, ka[hh]), k));
            const f32x2 s = *(const f32x2*)(sp + (hh * 64 + k) * 128);
            const f32x2 sn = s * fk + vv * kk;
            *(f32x2*)(so + (hh * 64 + k) * 128) = sn;
            o += sn * qk;
        }
    }
    const float ss = wave_sum(o[0] * o[0] + o[1] * o[1]);
    const float rstd = rsqrtf(ss * (1.f / 128.f) + EPS);
    const unsigned gw = *(const unsigned*)(G + rb + 2 * lane);
    const f32x2 hgv = *(const f32x2*)(a.in[I_HG] + h * 128 + 2 * lane);
    *(unsigned*)(A2 + (size_t)(MPROMPT + sb) * D + h * 128 + 2 * lane) = pk2(o[0] * rstd * hgv[0] * bflo(gw), o[1] * rstd * hgv[1] * bfhi(gw));
}
__device__ __forceinline__ void sample_stage(const Args& a, int lane, int wave) {
    const int nw = gridDim.x * 4;
    if (wave < 4) { for (int it = blockIdx.x * 4 + wave; it < NS * NH; it += nw) hgrn_sample_wave(a, it, lane); }
    else          { for (int it = blockIdx.x * 4 + (wave - 4); it < NS * 8; it += nw) conv_sample_wave(a, it, lane); }
}

__device__ __forceinline__ void final_norm(const Args& a, int lane, int wave) {
    RowMap R{a.in[I_XP], a.in[I_XS], a.in[I_META], a.out};
    const f32x4* g = (const f32x4*)a.in[I_GFIN]; const float* part = (const float*)(a.ws + WS_PART);
    for (int m = blockIdx.x * 8 + wave; m < MREAL; m += gridDim.x * 8) {
        float* dst = out_row(R, m); if (!dst) continue;
        f32x4* p = (f32x4*)dst + lane;
        f32x4 v[8];
#pragma unroll
        for (int j = 0; j < 8; ++j) v[j] = p[64 * j];
        if (m >= MAIN_ROWS) {
            for (int s = 0; s < NSLICE; ++s) { const f32x4* q = (const f32x4*)(part + ((size_t)s * 256 + (m - MAIN_ROWS)) * D) + lane;
#pragma unroll
                for (int j = 0; j < 8; ++j) v[j] += q[64 * j]; }
        }
        float ss = 0.f;
#pragma unroll
        for (int j = 0; j < 8; ++j) ss += (v[j][0] * v[j][0] + v[j][1] * v[j][1]) + (v[j][2] * v[j][2] + v[j][3] * v[j][3]);
        const float rstd = rsqrtf(wave_sum(ss) * (1.f / D) + EPS);
#pragma unroll
        for (int j = 0; j < 8; ++j) p[64 * j] = v[j] * rstd * g[lane + 64 * j];
    }
}

#define XB_TMO      128
#define XB_XCNT(j)  (256  + 64 * (j))
#define XB_XSUB(j)  (1280 + 64 * (j))
#define XB_XGEN(j)  (2304 + 64 * (j))
#define XB_TOP      3328
#define XB_TOPGEN   3392
#define XCD_BAR_WORDS 3456
#define XB_SPIN_CAP (1u << 18)

__device__ __forceinline__ unsigned xb_ld(unsigned* p)              { return __hip_atomic_load(p, __ATOMIC_RELAXED, __HIP_MEMORY_SCOPE_AGENT); }
__device__ __forceinline__ unsigned xb_add(unsigned* p, unsigned v) { return __hip_atomic_fetch_add(p, v, __ATOMIC_RELAXED, __HIP_MEMORY_SCOPE_AGENT); }
__device__ __forceinline__ unsigned xb_xcc_id() { return (unsigned)__builtin_amdgcn_s_getreg((3 << 11) | 20) & 0xFu; }
#define XB_SPIN(cond, bar) do { unsigned _sp = 0; while (cond) { __builtin_amdgcn_s_sleep(1); \
    if ((++_sp & 255u) == 0u) { if (xb_ld(&(bar)[XB_TMO])) break; if (_sp > XB_SPIN_CAP) { atomicAdd(&(bar)[XB_TMO], 1u); break; } } } } while (0)

struct XcdBarrier {
    unsigned* bar; unsigned x;
    volatile LAS unsigned* st;
};

__device__ __forceinline__ XcdBarrier xcd_barrier_post(unsigned* bar, volatile LAS unsigned* st) {
    XcdBarrier b; b.bar = bar; b.x = xb_xcc_id(); b.st = st;
    if (threadIdx.x == 0) (void)xb_add(&bar[XB_XCNT(b.x)], 1u);
    return b;
}
__device__ __forceinline__ void xcd_barrier_complete(unsigned* bar, unsigned x, unsigned& nloc, unsigned& nx) {
    const unsigned G = gridDim.x * gridDim.y * gridDim.z;
    unsigned sum, cnt, mine, sp = 0u;
    for (;;) {
        sum = 0u; cnt = 0u; mine = 0u;
#pragma unroll
        for (unsigned j = 0; j < 16; ++j) { const unsigned c = xb_ld(&bar[XB_XCNT(j)]); sum += c; cnt += (c > 0u) ? 1u : 0u; mine = (j == x) ? c : mine; }
        if (sum == G) break;
        __builtin_amdgcn_s_sleep(1);
        if ((++sp & 255u) == 0u) { if (xb_ld(&bar[XB_TMO])) break; if (sp > XB_SPIN_CAP) { atomicAdd(&bar[XB_TMO], 1u); break; } }
    }
    nloc = mine > 0u ? mine : 1u; nx = cnt > 0u ? cnt : 1u;
}

__device__ __forceinline__ void xcd_barrier(const XcdBarrier& b) {
    asm volatile("s_waitcnt vmcnt(0)" ::: "memory");
    __syncthreads();
    if (threadIdx.x == 0) {
        unsigned* bar = b.bar;
        __builtin_amdgcn_s_waitcnt(0);
        unsigned nloc = b.st[0], nx = b.st[1];
        if (nloc == 0u) { xcd_barrier_complete(bar, b.x, nloc, nx); b.st[0] = nloc; b.st[1] = nx; }
        const unsigned old = xb_add(&bar[XB_XSUB(b.x)], 1u);
        const unsigned gen = old / nloc;
        if (old + 1u == (gen + 1u) * nloc) {
            __builtin_amdgcn_fence(__ATOMIC_RELEASE, "agent");
            asm volatile("s_waitcnt vmcnt(0)" ::: "memory");
            const unsigned og = xb_add(&bar[XB_TOP], 1u);
            const unsigned tg = og / nx;
            if (og + 1u == (tg + 1u) * nx) xb_add(&bar[XB_TOPGEN], 1u);
            else XB_SPIN(xb_ld(&bar[XB_TOPGEN]) == tg, bar);
            __builtin_amdgcn_fence(__ATOMIC_ACQUIRE, "agent");
            xb_add(&bar[XB_XGEN(b.x)], 1u);
            asm volatile("s_waitcnt vmcnt(0)" ::: "memory");
        } else {
            XB_SPIN(xb_ld(&bar[XB_XGEN(b.x)]) == gen, bar);
            __builtin_amdgcn_fence(__ATOMIC_ACQUIRE, "agent");
            asm volatile("s_waitcnt vmcnt(0)" ::: "memory");
        }
    }
    __syncthreads();
}

constexpr int NPHASE = 9;
#ifndef REP_P0
#define REP_P0 1
#endif
#ifndef REP_G1
#define REP_G1 1
#endif
#ifndef REP_P2
#define REP_P2 1
#endif
#ifndef REP_SYNC
#define REP_SYNC 1
#endif
__global__ void __launch_bounds__(512, 2) hymba_fwd(Args args) {
    extern __shared__ __attribute__((aligned(16))) unsigned char lds_raw[];
    LAS unsigned char* lds = (LAS unsigned char*)lds_raw;
    cg::grid_group grid = cg::this_grid();
    const int tid = threadIdx.x, lane = tid & 63, wave = __builtin_amdgcn_readfirstlane(tid >> 6);
    unsigned char* ws = args.ws;
    const int lo = args.ph_lo, hi = args.ph_hi;
#define IN(k) (lo <= (k) && (k) < hi)
#define SEAM(k) do { if (IN(k) && IN((k) + 1)) { for (int rep_ = 0; rep_ < REP_SYNC; ++rep_) xcd_barrier(bar); } } while (0)
    RowMap R{args.in[I_XP], args.in[I_XS], args.in[I_META], args.out};
    if (lo < 0) grid.sync();
    if (tid < 64) ((LAS unsigned*)(lds + LDS_MISC))[tid] = 0u;
    __syncthreads();
    XcdBarrier bar; bar.bar = (unsigned*)(ws + WS_BAR); bar.x = 0; bar.st = nullptr;
    if (hi - lo > 1) bar = xcd_barrier_post((unsigned*)(ws + WS_BAR), (volatile LAS unsigned*)(lds + LDS_MISC) + 8);
    if (IN(0)) { for (int rep = 0; rep < REP_P0; ++rep) p0_prologue(args, lds, tid, lane, wave); }
    SEAM(0);
    if (IN(1)) for (int rep = 0; rep < REP_G1; ++rep) {
        pg8::Gemm g{(const bf16*)(ws + WS_XN), (const bf16*)(ws + WS_WIN), MP, NIN, D}; pg8::StaticOrder S; S.init(MP, NIN, gridDim.x, (int)blockIdx.x, D);
        EpiIn E{(bf16*)(ws + WS_QS), (float*)(ws + WS_LF), (bf16*)(ws + WS_V), (bf16*)(ws + WS_G), (bf16*)(ws + WS_U), (const float*)(ws + WS_CTL)};
        pg8::gemm_phase<EpiIn, pg8::StaticOrder, true, true>(lds, g, S, E);
        if (rep == 0) idle_slot_convert(args, lds, lane, wave, (MP / 256) * (NIN / 256), CV_A, CV_B);
    }
    SEAM(1);
    if (IN(2)) for (int rep = 0; rep < REP_P2; ++rep) { hgrn_local(args, lds, tid, lane, wave); conv_prompt(args, lds, tid, lane, wave); sample_stage(args, lane, wave); }
    SEAM(2);
    if (IN(3)) { hgrn_scan(args, tid); }
    SEAM(3);
    if (IN(4)) for (int rep = 0; rep < REP_P2; ++rep) { hgrn_out(args, lds, tid, lane, wave); }
    SEAM(4);
    if (IN(5)) {
        pg8::Gemm g{(const bf16*)(ws + WS_A2), (const bf16*)(ws + WS_WOUT), MP, D, D}; pg8::StaticOrder S; S.init(MP, D, gridDim.x, (int)blockIdx.x, D);
        EpiOut E{R, (bf16*)(ws + WS_XN), args.in[I_GFFN], (float*)(ws + WS_CTL) + 16384};
        pg8::gemm_phase<EpiOut, pg8::StaticOrder, true, true>(lds, g, S, E);
        idle_slot_convert(args, lds, lane, wave, (MP / 256) * (D / 256), CV_B, CV_END);
    }
    SEAM(5);
    if (IN(6)) {
        pg8::Gemm g{(const bf16*)(ws + WS_XN), (const bf16*)(ws + WS_WGU), MP, 2 * FF, D}; pg8::StaticOrder S; S.init(MP, 2 * FF, gridDim.x, (int)blockIdx.x, D);
        EpiGU E{(const float*)(ws + WS_CTL) + 16384, (bf16*)(ws + WS_A4)};
        pg8::gemm_phase<EpiGU, pg8::StaticOrder, true, true>(lds, g, S, E);
    }
    SEAM(6);
    if (IN(7)) {
        pg8::Gemm g{(const bf16*)(ws + WS_A4), (const bf16*)(ws + WS_WD), MP, D, FF}; SplitOrder S; S.init(MAIN_ROWS, D, gridDim.x, (int)blockIdx.x, FF);
        EpiDown E{R, (float*)(ws + WS_PART)};
        pg8::gemm_phase<EpiDown, SplitOrder, true, true>(lds, g, S, E);
    }
    SEAM(7);
    if (IN(8)) { final_norm(args, lane, wave); }
#undef IN
#undef SEAM
}

#ifndef MK_N_LAUNCHES
#define MK_N_LAUNCHES 1
#endif
extern "C" void kernel_launch(void* const* d_in, const int* in_sizes, int n_in, void* d_out, int out_size, void* d_ws, size_t ws_size, hipStream_t stream) {
    static int grid = 0;
    if (grid == 0) {
        if (n_in != 19 || (size_t)out_size != O_END || ws_size < WS_END) { fprintf(stderr, "kernel_launch: unexpected shapes: n_in %d out %d ws %zu (need %zu)\n", n_in, out_size, ws_size, (size_t)WS_END); grid = -1; return; }
        int dev = 0, cus = 0, per_cu = 0;
        if (hipGetDevice(&dev) != hipSuccess || hipDeviceGetAttribute(&cus, hipDeviceAttributeMultiprocessorCount, dev) != hipSuccess) { grid = -1; return; }
        if (hipFuncSetAttribute((const void*)hymba_fwd, hipFuncAttributeMaxDynamicSharedMemorySize, LDS_BYTES) != hipSuccess) { fprintf(stderr, "kernel_launch: hipFuncSetAttribute failed\n"); grid = -1; return; }
        if (hipOccupancyMaxActiveBlocksPerMultiprocessor(&per_cu, (const void*)hymba_fwd, 512, LDS_BYTES) != hipSuccess || per_cu < 1) { fprintf(stderr, "kernel_launch: occupancy query failed (%d)\n", per_cu); (void)hipGetLastError(); grid = -1; return; }
        grid = cus * per_cu;
        if (grid % 4 != 0) { fprintf(stderr, "kernel_launch: grid %d is not a multiple of 4\n", grid); grid = -1; return; }
        fprintf(stderr, "kernel_launch: grid %d (%d CUs x %d)\n", grid, cus, per_cu);
    }
    if (grid < 0) return;
    if (hipMemsetAsync((char*)d_ws + WS_BAR, 0, BAR_BYTES, stream) != hipSuccess) { fprintf(stderr, "kernel_launch: memset failed\n"); return; }
    Args a{};
    for (int i = 0; i < 19; ++i) a.in[i] = (const float*)d_in[i];
    a.out = (float*)d_out; a.ws = (unsigned char*)d_ws;
#if MK_N_LAUNCHES == 1
    a.ph_lo = 0; a.ph_hi = NPHASE;
    void* kargs[] = {&a};
    hipError_t e = hipLaunchCooperativeKernel((const void*)hymba_fwd, dim3(grid), dim3(512), kargs, LDS_BYTES, stream);
    if (e != hipSuccess) fprintf(stderr, "kernel_launch: cooperative launch failed: %s (grid %d)\n", hipGetErrorString(e), grid);
#else
    for (int p = 0; p < NPHASE; ++p) { a.ph_lo = p; a.ph_hi = p + 1; hipLaunchKernelGGL(hymba_fwd, dim3(grid), dim3(512), LDS_BYTES, stream, a); }
#endif
}
```
